# Optimizing an MI355X kernel written in HIP

```python
import jax, jax.numpy as jnp
from jax import lax
import numpy as np

D_MODEL = 2048
BATCH = 2
SEQ = 16384
DEPTH = 1

D_MIX = D_MODEL
HEAD_DIM = 64
N_Q_HEADS = 16
N_KV_HEADS = 4
Q_PER_KV = N_Q_HEADS // N_KV_HEADS
ATTN_WIDTH = N_Q_HEADS * HEAD_DIM
KV_WIDTH = N_KV_HEADS * HEAD_DIM
WINDOW = 128
BLOCK = 128
ROT_DIM = HEAD_DIM // 4
ROPE_THETA = 500000.0
CHUNK = 128
GMLP_GROUP_DIM = 128
GMLP_WIDTH = D_MIX - ATTN_WIDTH
N_GMLP_GROUPS = GMLP_WIDTH // GMLP_GROUP_DIM
IN_COLS = ATTN_WIDTH + 2 * KV_WIDTH + 2 * GMLP_WIDTH
D_FF = 5632
EPS = 1e-6
NEG_INF = -1e30

kernel_name = "hymba_swa_sink_gmlp_macaron"


def rmsnorm(x, g):
    xf = x.astype(jnp.float32)
    y = xf * lax.rsqrt(jnp.mean(xf * xf, axis=-1, keepdims=True) + EPS)
    return (y * g.astype(jnp.float32)).astype(x.dtype)


def swiglu(h, w_gate, w_up, w_down):
    return (jax.nn.silu(h @ w_gate) * (h @ w_up)) @ w_down


def rope_tables(positions, dtype):
    inv_freq = ROPE_THETA ** (-jnp.arange(0, ROT_DIM, 2, dtype=jnp.float32) / ROT_DIM)
    ang = positions.astype(jnp.float32)[..., None] * inv_freq
    return jnp.cos(ang)[:, :, None, :].astype(dtype), jnp.sin(ang)[:, :, None, :].astype(dtype)


def partial_rope(t, cos, sin):
    half = ROT_DIM // 2
    t1, t2, rest = t[..., :half], t[..., half:ROT_DIM], t[..., ROT_DIM:]
    return jnp.concatenate([t1 * cos - t2 * sin, t2 * cos + t1 * sin, rest], axis=-1)


def band(t):
    b, s, h, d = t.shape
    tb = t.reshape(b, s // BLOCK, BLOCK, h, d)
    prev = jnp.pad(tb, ((0, 0), (1, 0), (0, 0), (0, 0), (0, 0)))[:, :-1]
    return jnp.concatenate([prev, tb], axis=2)


def sliding_window_attention_with_sinks(q, k, v, sinks):
    b, s = q.shape[:2]
    nb = s // BLOCK
    qb = q.reshape(b, nb, BLOCK, N_KV_HEADS, Q_PER_KV, HEAD_DIM)
    kb, vb = band(k), band(v)
    scores = jnp.einsum('bnqhgd,bnkhd->bnhgqk', qb, kb,
                        preferred_element_type=jnp.float32) * (HEAD_DIM ** -0.5)
    qi = jnp.arange(BLOCK)[:, None]
    kj = jnp.arange(2 * BLOCK)[None, :]
    diff = qi + BLOCK - kj
    blk = jnp.arange(nb)[:, None, None]
    valid = (diff >= 0) & (diff < WINDOW) & (blk * BLOCK + kj - BLOCK >= 0)
    scores = jnp.where(valid[None, :, None, None], scores, NEG_INF)
    sink = sinks.astype(jnp.float32).reshape(N_KV_HEADS, Q_PER_KV)[None, None, :, :, None, None]
    m = jnp.maximum(jnp.max(scores, axis=-1, keepdims=True), sink)
    p = jnp.exp(scores - m)
    p = p / (jnp.sum(p, axis=-1, keepdims=True) + jnp.exp(sink - m))
    out = jnp.einsum('bnhgqk,bnkhd->bnqhgd', p.astype(v.dtype), vb)
    return out.reshape(b, s, ATTN_WIDTH)


def chunked_spatial_gating(u, v, w_s, b_s):
    b, s = u.shape[:2]
    nc = s // CHUNK
    v4 = v.reshape(b, nc, CHUNK, N_GMLP_GROUPS, GMLP_GROUP_DIM)
    causal = jnp.tril(jnp.ones((CHUNK, CHUNK), dtype=bool))
    w = jnp.where(causal[None], w_s, jnp.zeros_like(w_s))
    sp = jnp.einsum('gts,bnsgc->bntgc', w, v4) + b_s.T[None, None, :, :, None]
    return u * sp.reshape(b, s, GMLP_WIDTH)


def setup_inputs(seed: int = 0) -> dict:
    key = jax.random.key(seed)
    ks = jax.random.split(key, 24)
    f32 = jnp.float32

    def nrm(k, shape, scale):
        return jax.random.normal(k, shape, f32) * scale

    def gain(k, shape):
        return 1.0 + 0.1 * jax.random.normal(k, shape, f32)

    L = DEPTH
    x = jax.random.normal(ks[0], (BATCH, SEQ, D_MODEL), f32)
    positions = (jnp.arange(SEQ, dtype=jnp.int32)[None, :]
                 + jax.random.randint(ks[1], (BATCH, 1), 0, 4096, dtype=jnp.int32))
    return {
        "x": x,
        "positions": positions,
        "ffn1_norm": gain(ks[2], (L, D_MODEL)),
        "ffn1_w_gate": nrm(ks[3], (L, D_MODEL, D_FF), D_MODEL ** -0.5),
        "ffn1_w_up": nrm(ks[4], (L, D_MODEL, D_FF), D_MODEL ** -0.5),
        "ffn1_w_down": nrm(ks[5], (L, D_FF, D_MODEL), D_FF ** -0.5),
        "mix_norm": gain(ks[6], (L, D_MODEL)),
        "w_in": nrm(ks[7], (L, D_MODEL, IN_COLS), D_MODEL ** -0.5),
        "q_norm": gain(ks[8], (L, HEAD_DIM)),
        "k_norm": gain(ks[9], (L, HEAD_DIM)),
        "attn_sinks": nrm(ks[10], (L, N_Q_HEADS), 1.0),
        "gmlp_v_norm": gain(ks[11], (L, GMLP_WIDTH)),
        "gmlp_w_s": nrm(ks[12], (L, N_GMLP_GROUPS, CHUNK, CHUNK), CHUNK ** -0.5),
        "gmlp_b_s": 1.0 + 0.1 * jax.random.normal(ks[13], (L, N_GMLP_GROUPS, CHUNK), f32),
        "attn_out_norm": gain(ks[14], (L, ATTN_WIDTH)),
        "gmlp_out_norm": gain(ks[15], (L, GMLP_WIDTH)),
        "w_out": nrm(ks[16], (L, D_MIX, D_MODEL), D_MIX ** -0.5),
        "ffn2_norm": gain(ks[17], (L, D_MODEL)),
        "ffn2_w_gate": nrm(ks[18], (L, D_MODEL, D_FF), D_MODEL ** -0.5),
        "ffn2_w_up": nrm(ks[19], (L, D_MODEL, D_FF), D_MODEL ** -0.5),
        "ffn2_w_down": nrm(ks[20], (L, D_FF, D_MODEL), D_FF ** -0.5),
    }


def reference(x, positions, ffn1_norm, ffn1_w_gate, ffn1_w_up, ffn1_w_down, mix_norm, w_in,
              q_norm, k_norm, attn_sinks, gmlp_v_norm, gmlp_w_s, gmlp_b_s, attn_out_norm,
              gmlp_out_norm, w_out, ffn2_norm, ffn2_w_gate, ffn2_w_up, ffn2_w_down):
    b, s, _ = x.shape
    cos, sin = rope_tables(positions, x.dtype)
    splits = np.cumsum([ATTN_WIDTH, KV_WIDTH, KV_WIDTH, GMLP_WIDTH]).tolist()
    for l in range(DEPTH):
        x = x + 0.5 * swiglu(rmsnorm(x, ffn1_norm[l]), ffn1_w_gate[l], ffn1_w_up[l], ffn1_w_down[l])

        h = rmsnorm(x, mix_norm[l])
        z = h @ w_in[l]
        q, k, v, gu, gv = jnp.split(z, splits, axis=-1)

        q = rmsnorm(q.reshape(b, s, N_Q_HEADS, HEAD_DIM), q_norm[l])
        k = rmsnorm(k.reshape(b, s, N_KV_HEADS, HEAD_DIM), k_norm[l])
        v = v.reshape(b, s, N_KV_HEADS, HEAD_DIM)
        q = partial_rope(q, cos, sin)
        k = partial_rope(k, cos, sin)
        a_out = sliding_window_attention_with_sinks(q, k, v, attn_sinks[l])

        gu = jax.nn.gelu(gu)
        gv = jax.nn.gelu(gv).reshape(b, s, N_GMLP_GROUPS, GMLP_GROUP_DIM)
        gv = rmsnorm(gv, gmlp_v_norm[l].reshape(N_GMLP_GROUPS, GMLP_GROUP_DIM)).reshape(b, s, GMLP_WIDTH)
        g_out = chunked_spatial_gating(gu, gv, gmlp_w_s[l], gmlp_b_s[l])

        mixed = jnp.concatenate([rmsnorm(a_out, attn_out_norm[l]),
                                 rmsnorm(g_out, gmlp_out_norm[l])], axis=-1)
        x = x + mixed @ w_out[l]

        x = x + 0.5 * swiglu(rmsnorm(x, ffn2_norm[l]), ffn2_w_gate[l], ffn2_w_up[l], ffn2_w_down[l])
    return x
```

```cpp
#include <hip/hip_runtime.h>
#include <hip/hip_cooperative_groups.h>
#include <cstdio>
#include <cstdint>
namespace cg = cooperative_groups;
namespace pg8 {
#define PG8_LAS __attribute__((address_space(3)))
typedef unsigned short bf16_t;
typedef short bf16x8 __attribute__((ext_vector_type(8)));
typedef float f32x4 __attribute__((ext_vector_type(4)));
typedef unsigned u32x4 __attribute__((ext_vector_type(4)));
constexpr int BM = 256, BK = 64, HALF = 128, HTB = HALF * BK * 2  , STAGE_BYTES = 8 * HTB, NXCD = 8, WGM = 8;

__host__ __device__ __forceinline__ int lds_byte(int r, int c) { const int st = (r >> 4) * 2 + (c >> 5), rr = r & 15, cc = c & 31, ob = rr * 64 + cc * 2; return st * 1024 + (ob ^ (((ob >> 9) & 1) << 5)); }
__host__ __device__ __forceinline__ void stage_rc(int b, int& R, int& C) { const int st = b / 1024, sb = b % 1024, swz = sb ^ (((sb >> 9) & 1) << 5); R = (st >> 1) * 16 + swz / 64; C = (st & 1) * 32 + (swz % 64) / 2; }
__host__ __device__ __forceinline__ int perm32(int rho) { const int n = rho >> 4, i = rho & 15; return 8 * (i >> 2) + 4 * n + (i & 3); }

struct Unit { int pm, pn; };
struct Gemm { const bf16_t* A; const bf16_t* Bt; int M, N, K; };

struct StaticOrder {
    int nM, nN, nwg, G, c;
    __host__ __device__ void init(int M, int N, int G_, int c_) { nM = M / BM; nN = N / BM; nwg = nM * nN; G = G_; c = c_; }
    __host__ __device__ bool next(int i, Unit& u) const {
        const long L = (long)i * G + c; if (L >= nwg) return false;
        int wgid = (int)L; { const int q = nwg / NXCD, r = nwg % NXCD, xcd = wgid % NXCD, off = wgid / NXCD; wgid = (xcd < r ? xcd * (q + 1) : r * (q + 1) + (xcd - r) * q) + off; }
        const int nig = WGM * nN, gid = wgid / nig, fm = gid * WGM, gsz = (nM - fm) < WGM ? (nM - fm) : WGM;
        u.pm = fm + ((wgid % nig) % gsz); u.pn = (wgid % nig) / gsz; return true;
    }
    __device__ __forceinline__ void a_ready(const Unit&) const {}
    __device__ __forceinline__ void done(const Unit&) const {}
};
__device__ __forceinline__ unsigned cvt_pk_bf16(float lo, float hi) { unsigned r; asm volatile("v_cvt_pk_bf16_f32 %0, %1, %2" : "=v"(r) : "v"(lo), "v"(hi)); return r; }
typedef unsigned u32x2 __attribute__((ext_vector_type(2)));
typedef int i32x8 __attribute__((ext_vector_type(8)));
typedef int i32x4 __attribute__((ext_vector_type(4)));
__device__ __forceinline__ i32x8 cat8(const bf16x8 a, const bf16x8 b) { const i32x4 x = __builtin_bit_cast(i32x4, a), y = __builtin_bit_cast(i32x4, b); return __builtin_shufflevector(x, y, 0, 1, 2, 3, 4, 5, 6, 7); }
__device__ __forceinline__ float clamp448(float v) { return __builtin_amdgcn_fmed3f(v, -448.0f, 448.0f); }
__device__ __forceinline__ unsigned pack4_fp8(const f32x4 v) { int w = __builtin_amdgcn_cvt_pk_fp8_f32(clamp448(v[0]), clamp448(v[1]), 0, false); w = __builtin_amdgcn_cvt_pk_fp8_f32(clamp448(v[2]), clamp448(v[3]), w, true); return (unsigned)w; }
__device__ __forceinline__ float fast_rcp(float x) { return __builtin_amdgcn_rcpf(x); }
__device__ __forceinline__ float fast_exp(float x) { return __builtin_amdgcn_exp2f(x * 1.4426950408889634f); }
__device__ __forceinline__ float silu_f(float g) { return g * fast_rcp(1.0f + fast_exp(-g)); }
__device__ __forceinline__ float gelu_t(float x) { const float u = 0.7978845608028654f * (x + 0.044715f * x * x * x); return x * fast_rcp(1.0f + fast_exp(-2.0f * u)); }
__device__ __forceinline__ u32x4 pack8(const f32x4 a, const f32x4 b) { u32x4 w; w.x = cvt_pk_bf16(a[0], a[1]); w.y = cvt_pk_bf16(a[2], a[3]); w.z = cvt_pk_bf16(b[0], b[1]); w.w = cvt_pk_bf16(b[2], b[3]); return w; }
__device__ __forceinline__ float dot4(const f32x4 a) { return (a[0] * a[0] + a[1] * a[1]) + (a[2] * a[2] + a[3] * a[3]); }

template <bool F8OUT, bool I8IN = false> struct EpiSwiglu {
    static constexpr bool PERM = true, AFTER_DRAIN = false;
    bf16_t* H; const float* rs; int ldh; float hscale; const unsigned* colmax;
    __device__ __forceinline__ void mid(f32x4 (&)[2][2][4][2], const Unit&, int, int, int, int) const {}
    __device__ __forceinline__ void pre(float (&p)[8], const Unit& u, int wr, int fr) const {
#pragma unroll
        for (int i = 0; i < 8; ++i) p[i] = rs[u.pm * BM + wr * 64 + fr + (i >> 2) * HALF + (i & 3) * 16];
    }
    __device__ __forceinline__ void operator()(const f32x4 (&acc)[2][2][4][2], const Unit& u, int wr, int wc, int fr, int fq, const float (&pr)[8]) const {
        const int row0 = u.pm * BM + wr * 64 + fr, col0 = u.pn * 128 + wc * 32 + 8 * fq;
        f32x4 csg[2], csu[2];
        if constexpr (I8IN) {
#pragma unroll
            for (int n = 0; n < 2; ++n) { const u32x4 a = *(const u32x4*)(colmax + u.pn * BM + wc * 32 + 8 * fq + 4 * n), b = *(const u32x4*)(colmax + u.pn * BM + HALF + wc * 32 + 8 * fq + 4 * n);
                csg[n] = (f32x4){__uint_as_float(a.x), __uint_as_float(a.y), __uint_as_float(a.z), __uint_as_float(a.w)} * (1.0f / 127.0f);
                csu[n] = (f32x4){__uint_as_float(b.x), __uint_as_float(b.y), __uint_as_float(b.z), __uint_as_float(b.w)} * (1.0f / 127.0f); }
        }
#pragma unroll
        for (int ai = 0; ai < 2; ++ai)
#pragma unroll
            for (int m = 0; m < 4; ++m) { const int row = row0 + ai * HALF + m * 16; const float s = pr[ai * 4 + m];
                f32x4 h[2];
#pragma unroll
                for (int n = 0; n < 2; ++n) { f32x4 g, uu;
                    if constexpr (I8IN) { const i32x4 gi = __builtin_bit_cast(i32x4, acc[ai][0][m][n]), ui = __builtin_bit_cast(i32x4, acc[ai][1][m][n]);
                        g = (f32x4){(float)gi[0], (float)gi[1], (float)gi[2], (float)gi[3]} * (csg[n] * s); uu = (f32x4){(float)ui[0], (float)ui[1], (float)ui[2], (float)ui[3]} * (csu[n] * s); }
                    else { g = acc[ai][0][m][n] * s; uu = acc[ai][1][m][n] * s; }
#pragma unroll
                    for (int j = 0; j < 4; ++j) h[n][j] = silu_f(g[j]) * uu[j]; }
                if constexpr (F8OUT) { u32x2 w; w.x = pack4_fp8(h[0] * hscale); w.y = pack4_fp8(h[1] * hscale); *(u32x2*)((unsigned char*)H + (size_t)row * ldh + col0) = w; }
                else *(u32x4*)(H + (size_t)row * ldh + col0) = pack8(h[0], h[1]); }
    }
};

__device__ __forceinline__ f32x4 bflo(const u32x4 w) { return (f32x4){__uint_as_float(w.x << 16), __uint_as_float(w.x & 0xffff0000u), __uint_as_float(w.y << 16), __uint_as_float(w.y & 0xffff0000u)}; }
__device__ __forceinline__ f32x4 bfhi(const u32x4 w) { return (f32x4){__uint_as_float(w.z << 16), __uint_as_float(w.z & 0xffff0000u), __uint_as_float(w.w << 16), __uint_as_float(w.w & 0xffff0000u)}; }
template <bool ROWSCALE, bool WB, bool WF> struct EpiResid {
    static constexpr bool PERM = true, AFTER_DRAIN = false;
    float* out; bf16_t* xb; float* part; const float* rsA; const float* rsB; float alpha; float* partmax;
    __device__ __forceinline__ void pre(float (&p)[8], const Unit& u, int wr, int fr) const {
        if constexpr (ROWSCALE) {
#pragma unroll
            for (int i = 0; i < 8; ++i) p[i] = rsB[u.pm * BM + wr * 64 + fr + (i >> 2) * HALF + (i & 3) * 16];
        }
    }
    __device__ __forceinline__ void mid(f32x4 (&acc)[2][2][4][2], const Unit& u, int wr, int wc, int fr, int fq) const {
        if constexpr (ROWSCALE) {
            const int row0 = u.pm * BM + wr * 64 + fr; float r[8];
#pragma unroll
            for (int i = 0; i < 8; ++i) r[i] = rsA[row0 + (i >> 2) * HALF + (i & 3) * 16];
#pragma unroll
            for (int ai = 0; ai < 2; ++ai)
#pragma unroll
                for (int m = 0; m < 4; ++m)
#pragma unroll
                    for (int bj = 0; bj < 2; ++bj)
#pragma unroll
                        for (int n = 0; n < 2; ++n) acc[ai][bj][m][n] = acc[ai][bj][m][n] * r[ai * 4 + m];
        }
    }
    __device__ __forceinline__ void operator()(const f32x4 (&acc)[2][2][4][2], const Unit& u, int wr, int wc, int fr, int fq, const float (&pr)[8]) const {
        int row0 = u.pm * BM + wr * 64 + fr, col0 = u.pn * BM + wc * 32 + 8 * fq;
        asm volatile("" : "+v"(row0), "+v"(col0));
        constexpr int DEPTH = 8;
        u32x4 rb[16];
#pragma unroll
        for (int st = 0; st < DEPTH; ++st) rb[st] = *(const u32x4*)(xb + (size_t)(row0 + (st >> 3) * HALF + ((st >> 1) & 3) * 16) * 2048 + col0 + (st & 1) * HALF);
        float ss = 0.f, mxv = 0.f;
#pragma unroll
        for (int st = 0; st < 16; ++st) { const int ai = st >> 3, m = (st >> 1) & 3, bj = st & 1; const int row = row0 + ai * HALF + m * 16;
            float a = alpha; if constexpr (ROWSCALE) a = pr[ai * 4 + m];
            const size_t off = (size_t)row * 2048 + col0 + bj * HALF;
            const f32x4 v0 = bflo(rb[st]) + acc[ai][bj][m][0] * a, v1 = bfhi(rb[st]) + acc[ai][bj][m][1] * a;
            if constexpr (WF) { *(f32x4*)(out + off) = v0; *(f32x4*)(out + off + 4) = v1; }
            if constexpr (WB) { *(u32x4*)(xb + off) = pack8(v0, v1); ss += dot4(v0) + dot4(v1);
                if constexpr (ROWSCALE) { const f32x4 a0 = __builtin_elementwise_abs(v0), a1 = __builtin_elementwise_abs(v1); mxv = fmaxf(mxv, fmaxf(fmaxf(fmaxf(a0[0], a0[1]), fmaxf(a0[2], a0[3])), fmaxf(fmaxf(a1[0], a1[1]), fmaxf(a1[2], a1[3])))); }
                if (bj == 1) { ss += __shfl_xor(ss, 16); ss += __shfl_xor(ss, 32); if (fq == 0) part[(size_t)row * 32 + u.pn * 4 + wc] = ss; ss = 0.f;
                    if constexpr (ROWSCALE) { mxv = fmaxf(mxv, __shfl_xor(mxv, 16)); mxv = fmaxf(mxv, __shfl_xor(mxv, 32)); if (fq == 0) partmax[(size_t)row * 32 + u.pn * 4 + wc] = mxv; mxv = 0.f; } } }
            if (st + DEPTH < 16) { const int s2 = st + DEPTH; rb[s2] = *(const u32x4*)(xb + (size_t)(row0 + (s2 >> 3) * HALF + ((s2 >> 1) & 3) * 16) * 2048 + col0 + (s2 & 1) * HALF); } }
    }
};

struct EpiIn {
    static constexpr bool PERM = true, AFTER_DRAIN = false;
    bf16_t *Q, *Kb, *Vb, *GU, *GV; const float *rs2, *qn, *kn, *gvn, *cs; float* partG;
    __device__ __forceinline__ void mid(f32x4 (&)[2][2][4][2], const Unit&, int, int, int, int) const {}
    __device__ __forceinline__ void pre(float (&p)[8], const Unit& u, int wr, int fr) const {
#pragma unroll
        for (int i = 0; i < 8; ++i) p[i] = rs2[u.pm * BM + wr * 64 + fr + (i >> 2) * HALF + (i & 3) * 16];
    }
    __device__ __forceinline__ void operator()(const f32x4 (&acc)[2][2][4][2], const Unit& u, int wr, int wc, int fr, int fq, const float (&pr)[8]) const {
        const int row0 = u.pm * BM + wr * 64 + fr, pn = u.pn;
        if (pn <= 4) {
            const bool isq = pn < 4; const float* gn = isq ? qn : kn; const float osc = isq ? 0.125f * 1.4426950408889634f : 1.0f;
            bf16_t* dst = isq ? (Q + (pn * 4 + wc) * 64 + 16 * fq) : (Kb + wc * 64 + 16 * fq); const int ld = isq ? 1024 : 256;
            f32x4 gg[2][2];
#pragma unroll
            for (int bj = 0; bj < 2; ++bj)
#pragma unroll
                for (int n = 0; n < 2; ++n) gg[bj][n] = *(const f32x4*)(gn + 16 * fq + 8 * n + 4 * bj) * osc;
            f32x4 ccur[4];
#pragma unroll
            for (int q = 0; q < 4; ++q) ccur[q] = *(const f32x4*)(cs + (size_t)row0 * 16 + 4 * q);
#pragma unroll
            for (int ai = 0; ai < 2; ++ai)
#pragma unroll
                for (int m = 0; m < 4; ++m) { const int row = row0 + ai * HALF + m * 16; const float s = pr[ai * 4 + m];
                    f32x4 cnx[4];
#pragma unroll
                    for (int q = 0; q < 4; ++q) cnx[q] = ccur[q];
                    if (ai * 4 + m + 1 < 8) { const int i2 = ai * 4 + m + 1; const float* csn = cs + (size_t)(row0 + (i2 >> 2) * HALF + (i2 & 3) * 16) * 16;
#pragma unroll
                        for (int q = 0; q < 4; ++q) cnx[q] = *(const f32x4*)(csn + 4 * q); }
                    f32x4 v[2][2]; float ss = 0.f;
#pragma unroll
                    for (int bj = 0; bj < 2; ++bj)
#pragma unroll
                        for (int n = 0; n < 2; ++n) { v[bj][n] = acc[ai][bj][m][n] * s; ss += dot4(v[bj][n]); }
                    ss += __shfl_xor(ss, 16); ss += __shfl_xor(ss, 32);
                    const float rn = __builtin_amdgcn_rsqf(ss * (1.0f / 64.0f) + 1e-6f);
#pragma unroll
                    for (int bj = 0; bj < 2; ++bj)
#pragma unroll
                        for (int n = 0; n < 2; ++n) v[bj][n] = v[bj][n] * rn * gg[bj][n];
#pragma unroll
                    for (int bj = 0; bj < 2; ++bj) { const f32x4 cc = ccur[bj], sn = ccur[2 + bj];
                        const f32x4 x1 = v[bj][0], x2 = v[bj][1]; const f32x4 r1 = x1 * cc - x2 * sn, r2 = x2 * cc + x1 * sn;
                        if (fq == 0) { v[bj][0] = r1; v[bj][1] = r2; } }
                    bf16_t* p = dst + (size_t)row * ld;
                    *(u32x4*)p = pack8(v[0][0], v[1][0]); *(u32x4*)(p + 8) = pack8(v[0][1], v[1][1]);
#pragma unroll
                    for (int q = 0; q < 4; ++q) ccur[q] = cnx[q]; }
        } else if (pn == 5) {
#pragma unroll
            for (int ai = 0; ai < 2; ++ai)
#pragma unroll
                for (int m = 0; m < 4; ++m) { const int row = row0 + ai * HALF + m * 16; const float s = pr[ai * 4 + m];
#pragma unroll
                    for (int bj = 0; bj < 2; ++bj) *(u32x4*)(Vb + (size_t)row * 256 + bj * HALF + wc * 32 + 8 * fq) = pack8(acc[ai][bj][m][0] * s, acc[ai][bj][m][1] * s); }
        } else if (pn < 10) {
            const int colt = (pn - 6) * 256 + wc * 32 + 8 * fq;
#pragma unroll
            for (int ai = 0; ai < 2; ++ai)
#pragma unroll
                for (int m = 0; m < 4; ++m) { const int row = row0 + ai * HALF + m * 16; const float s = pr[ai * 4 + m];
#pragma unroll
                    for (int bj = 0; bj < 2; ++bj) { f32x4 y0 = acc[ai][bj][m][0] * s, y1 = acc[ai][bj][m][1] * s;
#pragma unroll
                        for (int j = 0; j < 4; ++j) { y0[j] = gelu_t(y0[j]); y1[j] = gelu_t(y1[j]); }
                        *(u32x4*)(GU + (size_t)row * 1024 + colt + bj * HALF) = pack8(y0, y1); } }
        } else {
            const int colt = (pn - 10) * 256 + wc * 32 + 8 * fq;
            f32x4 gg[2][2];
#pragma unroll
            for (int bj = 0; bj < 2; ++bj)
#pragma unroll
                for (int n = 0; n < 2; ++n) gg[bj][n] = *(const f32x4*)(gvn + colt + bj * HALF + 4 * n);
#pragma unroll
            for (int ai = 0; ai < 2; ++ai)
#pragma unroll
                for (int m = 0; m < 4; ++m) { const int row = row0 + ai * HALF + m * 16; const float s = pr[ai * 4 + m];
#pragma unroll
                    for (int bj = 0; bj < 2; ++bj) { f32x4 y0 = acc[ai][bj][m][0] * s, y1 = acc[ai][bj][m][1] * s;
#pragma unroll
                        for (int j = 0; j < 4; ++j) { y0[j] = gelu_t(y0[j]); y1[j] = gelu_t(y1[j]); }
                        float ss = dot4(y0) + dot4(y1); ss += __shfl_xor(ss, 16); ss += __shfl_xor(ss, 32);
                        if (fq == 0) partG[((size_t)row * 8 + (pn - 10) * 2 + bj) * 4 + wc] = ss;
                        *(u32x4*)(GV + (size_t)row * 1024 + colt + bj * HALF) = pack8(y0 * gg[bj][0], y1 * gg[bj][1]); } }
        }
    }
};

template <class Epi, class Sched, bool ALIGN_EPI = false, bool SP2 = false, int MIDK = 0, int MODE = 0>
__device__ __forceinline__ void gemm_phase(PG8_LAS unsigned char* lds, const Gemm g, const Sched& S, const Epi& E) {
    constexpr bool F8 = (MODE == 1), I8 = (MODE == 2);
    const int tid = threadIdx.x, wid = __builtin_amdgcn_readfirstlane(tid >> 6), lane = tid & 63, wr = wid >> 2, wc = wid & 3, fr = lane & 15, fq = lane >> 4;
    const int K = g.K, nt = K / BK;
    unsigned voffA[2], voffB[2];
#pragma unroll
    for (int i = 0; i < 2; ++i) { int R, C; stage_rc(tid * 16 + i * 8192, R, C); const int Rb = Epi::PERM ? ((R & ~31) + perm32(R & 31)) : R;
        voffA[i] = (unsigned)(R * K + C) * 2u; voffB[i] = (unsigned)(Rb * K + C) * 2u; }
    const size_t kstep = (size_t)(BK * 2);
    const size_t hstep = (size_t)HALF * K * 2;
    const size_t tstep = 2 * hstep;
    const unsigned ldsw = (unsigned)wid * 1024u;
    const int kc0 = F8 ? (32 * (fq >> 1) + 16 * (fq & 1)) : fq * 8;
    constexpr int KPIECE = F8 ? 16 : 1024;
    const int aoff = lds_byte(wr * 64 + fr, kc0), boff = lds_byte(wc * 32 + fr, kc0);
#define PG8_SA(b, h) (((b) * 2 + (h)) * HTB)
#define PG8_SB(b, h) ((4 + (b) * 2 + (h)) * HTB)
#define PG8_STAGE(bufoff, gbase, voff) do { _Pragma("unroll") for (int _i = 0; _i < 2; ++_i) \
        __builtin_amdgcn_global_load_lds((const unsigned*)((const char*)(gbase) + (voff)[_i]), (PG8_LAS unsigned*)(lds + (bufoff) + ldsw + _i * 8192), 16, 0, 0); } while (0)
#define PG8_LDA(dst, b, h) do { _Pragma("unroll") for (int m = 0; m < 4; ++m) { \
        if constexpr (F8) dst##8[m] = cat8(*(const PG8_LAS bf16x8*)(lds + PG8_SA(b, h) + aoff + m * 2048), *(const PG8_LAS bf16x8*)(lds + PG8_SA(b, h) + aoff + m * 2048 + KPIECE)); \
        else { _Pragma("unroll") for (int k = 0; k < 2; ++k) dst[m][k] = *(const PG8_LAS bf16x8*)(lds + PG8_SA(b, h) + aoff + m * 2048 + k * KPIECE); } } } while (0)
#define PG8_LDB(dst, b, h) do { _Pragma("unroll") for (int n = 0; n < 2; ++n) { \
        if constexpr (F8) dst##8[n] = cat8(*(const PG8_LAS bf16x8*)(lds + PG8_SB(b, h) + boff + n * 2048), *(const PG8_LAS bf16x8*)(lds + PG8_SB(b, h) + boff + n * 2048 + KPIECE)); \
        else { _Pragma("unroll") for (int k = 0; k < 2; ++k) dst[n][k] = *(const PG8_LAS bf16x8*)(lds + PG8_SB(b, h) + boff + n * 2048 + k * KPIECE); } } } while (0)
#define PG8_MMA(ai, bj, At, Bt) do { __builtin_amdgcn_s_setprio(1); _Pragma("unroll") for (int m = 0; m < 4; ++m) _Pragma("unroll") for (int n = 0; n < 2; ++n) { \
        if constexpr (F8) asm volatile("v_mfma_f32_16x16x128_f8f6f4 %0, %1, %2, %0" : "+v"(acc[ai][bj][m][n]) : "v"(Bt##8[n]), "v"(At##8[m]));   \
        else if constexpr (I8) { _Pragma("unroll") for (int k = 0; k < 2; ++k) acc[ai][bj][m][n] = __builtin_bit_cast(f32x4, __builtin_amdgcn_mfma_i32_16x16x64_i8(__builtin_bit_cast(i32x4, Bt[n][k]), __builtin_bit_cast(i32x4, At[m][k]), __builtin_bit_cast(i32x4, acc[ai][bj][m][n]), 0, 0, 0)); } \
        else { _Pragma("unroll") for (int k = 0; k < 2; ++k) acc[ai][bj][m][n] = __builtin_amdgcn_mfma_f32_16x16x32_bf16(Bt[n][k], At[m][k], acc[ai][bj][m][n], 0, 0, 0); } } __builtin_amdgcn_s_setprio(0); } while (0)
#define PG8_WAIT_V(n) asm volatile("s_waitcnt vmcnt(" #n ")" ::: "memory")
#define PG8_WAIT_L(n) asm volatile("s_waitcnt lgkmcnt(" #n ")" ::: "memory")
#define PG8_BAR __builtin_amdgcn_s_barrier()
#define PG8_SCHED __builtin_amdgcn_sched_barrier(0)
    Unit cur, nxt; int ui = 0;
    if (!S.next(0, cur)) return;
    f32x4 acc[2][2][4][2];
#pragma unroll
    for (int a = 0; a < 2; ++a)
#pragma unroll
        for (int b = 0; b < 2; ++b)
#pragma unroll
            for (int m = 0; m < 4; ++m)
#pragma unroll
                for (int n = 0; n < 2; ++n) acc[a][b][m][n] = (f32x4){0.f, 0.f, 0.f, 0.f};
    bf16x8 At[4][2], B0[2][2], B1[2][2]; i32x8 At8[4], B08[2], B18[2];
    float pre[8];
#pragma unroll
    for (int i = 0; i < 8; ++i) pre[i] = 0.f;
    const char* cA = (const char*)g.A + (size_t)cur.pm * tstep; const char* cB = (const char*)g.Bt + (size_t)cur.pn * tstep;
    S.a_ready(cur);
    if constexpr (SP2) {
        PG8_STAGE(PG8_SB(0, 0), cB, voffB); PG8_STAGE(PG8_SB(0, 1), cB + hstep, voffB); PG8_STAGE(PG8_SA(0, 0), cA, voffA); PG8_STAGE(PG8_SA(0, 1), cA + hstep, voffA);
        if (wr == 1) PG8_BAR;
        PG8_WAIT_V(2); PG8_BAR;
        PG8_STAGE(PG8_SB(1, 0), cB + kstep, voffB); PG8_STAGE(PG8_SA(1, 0), cA + kstep, voffA); PG8_STAGE(PG8_SB(1, 1), cB + hstep + kstep, voffB);
        PG8_WAIT_V(6); PG8_BAR;
    } else {
        PG8_STAGE(PG8_SB(0, 0), cB, voffB); PG8_STAGE(PG8_SA(0, 0), cA, voffA); PG8_STAGE(PG8_SB(0, 1), cB + hstep, voffB); PG8_STAGE(PG8_SA(0, 1), cA + hstep, voffA);
        if (wr == 1) PG8_BAR;
        PG8_WAIT_V(4); PG8_BAR;
        PG8_STAGE(PG8_SB(1, 0), cB + kstep, voffB); PG8_STAGE(PG8_SA(1, 0), cA + kstep, voffA); PG8_STAGE(PG8_SB(1, 1), cB + hstep + kstep, voffB);
        PG8_WAIT_V(6); PG8_BAR;
    }
    for (;;) {
        const bool has_next = S.next(ui + 1, nxt);
        const char* nA = has_next ? (const char*)g.A + (size_t)nxt.pm * tstep : cA; const char* nB = has_next ? (const char*)g.Bt + (size_t)nxt.pn * tstep : cB;
        for (int t = 0; t < nt; t += 2) {
            const bool last = (t == nt - 2);
            const char* a1 = cA + (size_t)(t + 1) * kstep;
            const char* a2 = last ? nA : cA + (size_t)(t + 2) * kstep; const char* b2 = last ? nB : cB + (size_t)(t + 2) * kstep;
            const char* a3 = a2 + kstep; const char* b3 = b2 + kstep;
            if (last && has_next) S.a_ready(nxt);
            if (last) E.pre(pre, cur, wr, fr);
            if constexpr (MIDK > 0) { if (t == MIDK / BK) E.mid(acc, cur, wr, wc, fr, fq); }
            if constexpr (SP2) {
            PG8_LDB(B0, 0, 0); PG8_LDB(B1, 0, 1); PG8_SCHED; PG8_LDA(At, 0, 0); PG8_STAGE(PG8_SA(1, 1), a1 + hstep, voffA);
            PG8_WAIT_V(8); PG8_WAIT_L(0); PG8_BAR; PG8_MMA(0, 0, At, B0); PG8_MMA(0, 1, At, B1); PG8_BAR; PG8_SCHED;
            PG8_LDA(At, 0, 1); PG8_STAGE(PG8_SB(0, 0), b2, voffB); PG8_STAGE(PG8_SB(0, 1), b2 + hstep, voffB); PG8_STAGE(PG8_SA(0, 0), a2, voffA);
            PG8_WAIT_V(8); PG8_WAIT_L(0); PG8_BAR; PG8_MMA(1, 0, At, B0); PG8_MMA(1, 1, At, B1); PG8_BAR; PG8_SCHED;
            PG8_LDB(B0, 1, 0); PG8_LDB(B1, 1, 1); PG8_SCHED; PG8_LDA(At, 1, 0); PG8_STAGE(PG8_SA(0, 1), a2 + hstep, voffA);
            PG8_WAIT_V(8); PG8_WAIT_L(0); PG8_BAR; PG8_MMA(0, 0, At, B0); PG8_MMA(0, 1, At, B1); PG8_BAR; PG8_SCHED;
            PG8_LDA(At, 1, 1); PG8_STAGE(PG8_SB(1, 0), b3, voffB); PG8_STAGE(PG8_SB(1, 1), b3 + hstep, voffB); PG8_STAGE(PG8_SA(1, 0), a3, voffA);
            PG8_WAIT_V(8); PG8_WAIT_L(0); PG8_BAR; PG8_MMA(1, 0, At, B0); PG8_MMA(1, 1, At, B1); PG8_BAR; PG8_SCHED;
            } else {
            PG8_LDB(B0, 0, 0); PG8_SCHED; PG8_LDA(At, 0, 0); PG8_STAGE(PG8_SA(1, 1), a1 + hstep, voffA);
            PG8_WAIT_L(8); PG8_BAR; PG8_WAIT_L(0); PG8_MMA(0, 0, At, B0); PG8_BAR; PG8_SCHED;
            PG8_LDB(B1, 0, 1); PG8_STAGE(PG8_SB(0, 0), b2, voffB);
            PG8_BAR; PG8_WAIT_L(0); PG8_MMA(0, 1, At, B1); PG8_BAR;
            PG8_LDA(At, 0, 1); PG8_STAGE(PG8_SA(0, 0), a2, voffA);
            PG8_BAR; PG8_WAIT_L(0); PG8_MMA(1, 0, At, B0); PG8_BAR; PG8_SCHED;
            PG8_STAGE(PG8_SB(0, 1), b2 + hstep, voffB);
            PG8_WAIT_V(6); PG8_BAR; PG8_MMA(1, 1, At, B1); PG8_BAR;
            PG8_LDB(B0, 1, 0); PG8_SCHED; PG8_LDA(At, 1, 0); PG8_STAGE(PG8_SA(0, 1), a2 + hstep, voffA);
            PG8_WAIT_L(8); PG8_BAR; PG8_WAIT_L(0); PG8_MMA(0, 0, At, B0); PG8_BAR; PG8_SCHED;
            PG8_LDB(B1, 1, 1); PG8_STAGE(PG8_SB(1, 0), b3, voffB);
            PG8_BAR; PG8_WAIT_L(0); PG8_MMA(0, 1, At, B1); PG8_BAR;
            PG8_LDA(At, 1, 1); PG8_STAGE(PG8_SA(1, 0), a3, voffA);
            PG8_BAR; PG8_WAIT_L(0); PG8_MMA(1, 0, At, B0); PG8_BAR; PG8_SCHED;
            PG8_STAGE(PG8_SB(1, 1), b3 + hstep, voffB);
            PG8_WAIT_V(6); PG8_BAR; PG8_MMA(1, 1, At, B1); PG8_BAR;
            }
        }
        if constexpr (F8) asm volatile("s_nop 15\n\ts_nop 15" ::: "memory");
        if constexpr (ALIGN_EPI) { if (wr == 0) PG8_BAR; }
        if constexpr (!Epi::AFTER_DRAIN) { E(acc, cur, wr, wc, fr, fq, pre); S.done(cur); }
        if (!has_next) break;
#pragma unroll
        for (int a = 0; a < 2; ++a)
#pragma unroll
            for (int b = 0; b < 2; ++b)
#pragma unroll
                for (int m = 0; m < 4; ++m)
#pragma unroll
                    for (int n = 0; n < 2; ++n) acc[a][b][m][n] = (f32x4){0.f, 0.f, 0.f, 0.f};
        cur = nxt; cA = nA; cB = nB; ++ui;
        if constexpr (ALIGN_EPI) { if (wr == 1) PG8_BAR; }
    }
    PG8_WAIT_V(0);
    if constexpr (!ALIGN_EPI) { if (wr == 0) PG8_BAR; }
    PG8_BAR;
    if constexpr (Epi::AFTER_DRAIN) { E.fused(acc, cur, wr, wc, fr, fq, lds, wid, lane); S.done(cur); }
#undef PG8_SA
#undef PG8_SB
#undef PG8_STAGE
#undef PG8_LDA
#undef PG8_LDB
#undef PG8_MMA
#undef PG8_WAIT_V
#undef PG8_WAIT_L
#undef PG8_BAR
#undef PG8_SCHED
}
}

constexpr int NWAVES = 8, NTHREADS = 512;
constexpr int BATCH = 2, SEQ = 16384, D = 2048, FF = 5632, NGU = 2 * FF, NIN = 3584;
constexpr int M = BATCH * SEQ;
constexpr float EPS = 1e-6f;
constexpr size_t MiB = 1u << 20;
constexpr size_t WS_WGU1 = 0, WS_WD1 = 44 * MiB, WS_WIN = 66 * MiB, WS_WOUT = 80 * MiB, WS_WGU2 = 88 * MiB, WS_WD2 = 132 * MiB;
constexpr size_t WS_WSB = 154 * MiB;
constexpr size_t WS_CS = 155 * MiB;
constexpr size_t WS_RS = 157 * MiB;
constexpr size_t WS_BAR = 157 * MiB + 768 * 1024;
constexpr size_t WS_PART = 158 * MiB;
constexpr size_t WS_PARTA = 162 * MiB;
constexpr size_t WS_PARTB = 164 * MiB;
constexpr size_t WS_PARTG = 165 * MiB;
constexpr size_t WS_XB = 170 * MiB;
constexpr size_t WS_H = 298 * MiB;
constexpr size_t WS_Q = WS_H, WS_K = WS_H + 64 * MiB, WS_V = WS_H + 80 * MiB, WS_GU = WS_H + 96 * MiB, WS_GV = WS_H + 160 * MiB, WS_AO = WS_H + 224 * MiB;
constexpr size_t WS_WGU2Q = WS_H + 352 * MiB;
constexpr size_t WS_AQ = WS_WGU2Q + 24 * MiB;
constexpr size_t WS_CMAX1 = WS_BAR + 16384, WS_CMAX2 = WS_CMAX1 + 45056;
constexpr size_t CTL_ZERO_BYTES = 16384 + 2 * 45056;
constexpr size_t WS_PMAX = WS_AQ + 64 * MiB;
constexpr size_t WS_WGU1Q = WS_PMAX + 4 * MiB;
constexpr size_t WS_END = WS_WGU1Q + 24 * MiB;
static_assert((size_t)M * FF * 2 == 352 * MiB && (size_t)M * D * 2 == 128 * MiB, "ws map");
constexpr int LDS_BYTES = 147456;

#define LAS __attribute__((address_space(3)))
typedef unsigned short bf16_t;
typedef short bf16x8 __attribute__((ext_vector_type(8)));
typedef float f32x4 __attribute__((ext_vector_type(4)));
typedef unsigned u32x4 __attribute__((ext_vector_type(4)));
typedef unsigned u32x2 __attribute__((ext_vector_type(2)));
using pg8::cvt_pk_bf16;
__device__ __forceinline__ float bf2f(unsigned b) { return __uint_as_float(b << 16); }
__device__ __forceinline__ float wave_sum(float v) {
#pragma unroll
    for (int o = 1; o < 64; o <<= 1) v += __shfl_xor(v, o);
    return v;
}

__device__ __forceinline__ int dest_row(int mode, int n) {
    if (mode == 0) return n;
    if (mode == 1) return ((n >> 7) << 8) + (n & 127);
    if (mode == 2) return ((n >> 7) << 8) + 128 + (n & 127);
    const int tile = n >> 8; if (tile > 4) return n;
    const int l = n & 255, wc = l >> 6, d = l & 63, fq = d >> 4, nn = (d >> 3) & 1, bj = (d >> 2) & 1, j = d & 3;
    return (tile << 8) + 128 * bj + 32 * wc + 8 * fq + 4 * nn + j;
}
struct ItemD { const float* W; const float* g0; const float* g1; unsigned char* WT; unsigned* cmax; int K, N, gsplit, mode, item; bool hasg, f8, track; };
__device__ __forceinline__ void item_load(const ItemD& d, float (&w)[32], float& gvec, int lane) {
    const int nblk = d.N / 32, kb = d.item / nblk, nb = d.item % nblk, k0 = 64 * kb, n0 = 32 * nb;
#pragma unroll
    for (int i = 0; i < 32; ++i) w[i] = d.W[(size_t)(k0 + 2 * i + (lane >> 5)) * d.N + n0 + (lane & 31)];
    gvec = 1.0f; if (d.hasg) { const int k = k0 + lane; gvec = (k < d.gsplit) ? d.g0[k] : d.g1[k - d.gsplit]; }
}
__device__ __forceinline__ void item_finish(const ItemD& d, const float (&w)[32], float gvec, LAS float* scr, int lane) {
    const int nblk = d.N / 32, kb = d.item / nblk, nb = d.item % nblk, k0 = 64 * kb, n0 = 32 * nb; float mx = 0.f;
    const int gbits = __float_as_int(gvec);
#pragma unroll
    for (int i = 0; i < 32; ++i) { const int kk = 2 * i + (lane >> 5);
        const float ga = __int_as_float(__builtin_amdgcn_readlane(gbits, 2 * i)), gb = __int_as_float(__builtin_amdgcn_readlane(gbits, 2 * i + 1));
        const float wv = w[i] * ((lane < 32) ? ga : gb); scr[kk * 33 + (lane & 31)] = wv; mx = fmaxf(mx, fabsf(wv)); }
    if (d.track) {
        mx = fmaxf(mx, __shfl_xor(mx, 32));
        if (lane < 32) __hip_atomic_fetch_max(d.cmax + dest_row(d.mode, n0 + lane), __float_as_uint(mx), __ATOMIC_RELAXED, __HIP_MEMORY_SCOPE_AGENT); }
    asm volatile("s_waitcnt lgkmcnt(0)" ::: "memory");
    const int c = lane & 7;
#pragma unroll
    for (int j = 0; j < 4; ++j) { const int n = (lane >> 3) + 8 * j; const LAS float* s = scr + (8 * c) * 33 + n; const size_t drow = (size_t)dest_row(d.mode, n0 + n);
        if (d.f8) { const f32x4 lo = (f32x4){s[0 * 33], s[1 * 33], s[2 * 33], s[3 * 33]} * 64.0f, hi = (f32x4){s[4 * 33], s[5 * 33], s[6 * 33], s[7 * 33]} * 64.0f;
            u32x2 o8; o8.x = pg8::pack4_fp8(lo); o8.y = pg8::pack4_fp8(hi); *(u32x2*)(d.WT + drow * d.K + k0 + 8 * c) = o8; }
        else { u32x4 o; o.x = cvt_pk_bf16(s[0 * 33], s[1 * 33]); o.y = cvt_pk_bf16(s[2 * 33], s[3 * 33]); o.z = cvt_pk_bf16(s[4 * 33], s[5 * 33]); o.w = cvt_pk_bf16(s[6 * 33], s[7 * 33]);
            *(u32x4*)((bf16_t*)d.WT + drow * d.K + k0 + 8 * c) = o; } }
    asm volatile("s_waitcnt lgkmcnt(0)" ::: "memory");
}

struct Args { const void* in[21]; float* out; unsigned char* ws; int ph_lo, ph_hi; };

__device__ __forceinline__ void p0_prologue(const Args& A, LAS unsigned char* lds, int tid) {
    const int lane = tid & 63, wave = __builtin_amdgcn_readfirstlane(tid >> 6);
    LAS float* scr = (LAS float*)(lds + wave * 16384);
    const int gw = blockIdx.x * NWAVES + wave, NGW = gridDim.x * NWAVES;
    unsigned char* ws = A.ws;
    constexpr int I_G = (D / 64) * (FF / 32), I_DN = (FF / 64) * (D / 32), I_IN = (D / 64) * (NIN / 32), I_O = (D / 64) * (D / 32);
    constexpr int NITEMS = 4 * I_G + 2 * I_DN + I_IN + I_O;
    auto decode = [&](int it) { ItemD d; int r = it; const float* one = (const float*)A.in[2];
        d.g0 = one; d.g1 = one; d.gsplit = 1 << 30; d.hasg = true; d.f8 = false; d.track = false; d.cmax = (unsigned*)(ws + WS_CMAX1); d.K = D; d.N = FF; d.mode = 0;
        if (r < I_G) { d.W = (const float*)A.in[3]; d.g0 = (const float*)A.in[2]; d.WT = ws + WS_WGU1; d.mode = 1; d.track = true; }
        else if ((r -= I_G) < I_G) { d.W = (const float*)A.in[4]; d.g0 = (const float*)A.in[2]; d.WT = ws + WS_WGU1; d.mode = 2; d.track = true; }
        else if ((r -= I_G) < I_DN) { d.W = (const float*)A.in[5]; d.K = FF; d.N = D; d.hasg = false; d.WT = ws + WS_WD1; }
        else if ((r -= I_DN) < I_IN) { d.W = (const float*)A.in[7]; d.N = NIN; d.g0 = (const float*)A.in[6]; d.WT = ws + WS_WIN; d.mode = 3; }
        else if ((r -= I_IN) < I_O) { d.W = (const float*)A.in[16]; d.N = D; d.g0 = (const float*)A.in[14]; d.g1 = (const float*)A.in[15]; d.gsplit = 1024; d.WT = ws + WS_WOUT; }
        else if ((r -= I_O) < I_G) { d.W = (const float*)A.in[18]; d.g0 = (const float*)A.in[17]; d.WT = ws + WS_WGU2; d.mode = 1; d.track = true; d.cmax = (unsigned*)(ws + WS_CMAX2); }
        else if ((r -= I_G) < I_G) { d.W = (const float*)A.in[19]; d.g0 = (const float*)A.in[17]; d.WT = ws + WS_WGU2; d.mode = 2; d.track = true; d.cmax = (unsigned*)(ws + WS_CMAX2); }
        else { r -= I_G; d.W = (const float*)A.in[20]; d.K = FF; d.N = D; d.hasg = false; d.f8 = true; d.WT = ws + WS_WD2; }
        d.item = r; return d; };
    if (gw < NITEMS) {
        ItemD dc = decode(gw); float wc_[32], wn_[32]; float gc = 1.f, gn = 1.f;
        item_load(dc, wc_, gc, lane);
        for (int it = gw; it < NITEMS; it += NGW) {
            const bool hn = it + NGW < NITEMS; ItemD dn = dc;
            if (hn) { dn = decode(it + NGW); item_load(dn, wn_, gn, lane); }
            item_finish(dc, wc_, gc, scr, lane);
            if (hn) { dc = dn; gc = gn;
#pragma unroll
                for (int i = 0; i < 32; ++i) wc_[i] = wn_[i]; }
        }
    }
    const float* x = (const float*)A.in[0]; bf16_t* XB = (bf16_t*)(ws + WS_XB); float* rs1 = (float*)(ws + WS_RS);
    f32x4 vnx[8];
    if (gw < M) {
#pragma unroll
        for (int j = 0; j < 8; ++j) vnx[j] = ((const f32x4*)(x + (size_t)gw * D) + lane)[64 * j]; }
    for (int m = gw; m < M; m += NGW) {
        u32x2* o = (u32x2*)(XB + (size_t)m * D) + lane; unsigned* oq = (unsigned*)(ws + WS_AQ + (size_t)m * D) + lane; float s = 0.f, mx = 0.f;
        f32x4 v[8];
#pragma unroll
        for (int j = 0; j < 8; ++j) v[j] = vnx[j];
        if (m + NGW < M) {
#pragma unroll
            for (int j = 0; j < 8; ++j) vnx[j] = ((const f32x4*)(x + (size_t)(m + NGW) * D) + lane)[64 * j]; }
#pragma unroll
        for (int j = 0; j < 8; ++j) { s += pg8::dot4(v[j]); const f32x4 a = __builtin_elementwise_abs(v[j]); mx = fmaxf(mx, fmaxf(fmaxf(a[0], a[1]), fmaxf(a[2], a[3])));
            u32x2 w; w.x = cvt_pk_bf16(v[j][0], v[j][1]); w.y = cvt_pk_bf16(v[j][2], v[j][3]); o[64 * j] = w; }
        s = wave_sum(s);
#pragma unroll
        for (int of = 1; of < 64; of <<= 1) mx = fmaxf(mx, __shfl_xor(mx, of));
        mx = fmaxf(mx, 1e-30f); const float qs = 127.0f / mx;
#pragma unroll
        for (int j = 0; j < 8; ++j) { const f32x4 q = v[j] * qs;
            oq[64 * j] = ((unsigned)(int)__builtin_rintf(q[0]) & 0xffu) | (((unsigned)(int)__builtin_rintf(q[1]) & 0xffu) << 8) | (((unsigned)(int)__builtin_rintf(q[2]) & 0xffu) << 16) | (((unsigned)(int)__builtin_rintf(q[3]) & 0xffu) << 24); }
        if (lane == 0) rs1[m] = __builtin_amdgcn_rsqf(s * (1.0f / D) + EPS) * mx * (1.0f / 127.0f);
    }
    const int gt = blockIdx.x * NTHREADS + tid, NGT = gridDim.x * NTHREADS;
    const float* wsp = (const float*)A.in[12]; bf16_t* WSB = (bf16_t*)(ws + WS_WSB);
    for (int i = gt; i < 8 * 128 * 128 / 2; i += NGT) { const int e = 2 * i, s = e & 127, t = (e >> 7) & 127;
        const float a = (s <= t) ? wsp[e] : 0.f, b = (s + 1 <= t) ? wsp[e + 1] : 0.f; ((unsigned*)WSB)[i] = cvt_pk_bf16(a, b); }
    const int* pos = (const int*)A.in[1]; float* cs = (float*)(ws + WS_CS);
    for (int i = gt; i < M * 8; i += NGT) { const int m = i >> 3, f = i & 7;
        float invf = 1.0f;
        invf = f == 1 ? 0.19392274f : invf; invf = f == 2 ? 0.03760603f : invf; invf = f == 3 ? 0.0072926646f : invf; invf = f == 4 ? 0.0014142136f : invf;
        invf = f == 5 ? 0.0002742482f : invf; invf = f == 6 ? 5.3182957e-05f : invf; invf = f == 7 ? 1.0313385e-05f : invf;
        const float ang = (float)pos[m] * invf;
        const double rev = (double)ang * 0.15915494309189535; const float fr = (float)(rev - __builtin_rint(rev));
        cs[(size_t)m * 16 + f] = __builtin_amdgcn_cosf(fr); cs[(size_t)m * 16 + 8 + f] = __builtin_amdgcn_sinf(fr); }
}

__device__ __forceinline__ unsigned q8pair(unsigned w, float sc) {
    const int a = (int)__builtin_rintf(__builtin_amdgcn_fmed3f(bf2f(w & 0xffffu) * sc, -127.0f, 127.0f)), b = (int)__builtin_rintf(__builtin_amdgcn_fmed3f(bf2f(w >> 16) * sc, -127.0f, 127.0f));
    return ((unsigned)a & 0xffu) | (((unsigned)b & 0xffu) << 8);
}
__device__ __forceinline__ u32x2 q8x8(const u32x4 w, float sc) { u32x2 o; o.x = q8pair(w.x, sc) | (q8pair(w.y, sc) << 16); o.y = q8pair(w.z, sc) | (q8pair(w.w, sc) << 16); return o; }
__device__ __forceinline__ void quantize_wgu(const unsigned char* srcb, unsigned char* dstb, const unsigned* cmax, int tid) {
    const u32x4* src = (const u32x4*)srcb; u32x2* dst = (u32x2*)dstb;
    for (int i = blockIdx.x * NTHREADS + tid; i < NGU * D / 8; i += gridDim.x * NTHREADS) {
        const float sc = 127.0f / fmaxf(__uint_as_float(__hip_atomic_load(cmax + (i >> 8), __ATOMIC_RELAXED, __HIP_MEMORY_SCOPE_AGENT)), 1e-30f);
        dst[i] = q8x8(src[i], sc); }
}
__device__ __forceinline__ void quantize_x2(unsigned char* ws, const float* part, float* rowfac, int tid) {
    const int lane = tid & 63, gw = blockIdx.x * NWAVES + (tid >> 6), NGW = gridDim.x * NWAVES;
    const bf16_t* XB = (const bf16_t*)(ws + WS_XB); unsigned char* AQ = ws + WS_AQ; const float* pmax = (const float*)(ws + WS_PMAX);
    constexpr int NR = 4;
    for (int m0 = gw; m0 < M; m0 += NR * NGW) {
        float p[NR], mx[NR]; u32x4 v[NR][4];
#pragma unroll
        for (int r = 0; r < NR; ++r) { const int m = m0 + r * NGW; const bool ok = m < M; const size_t mm = ok ? (size_t)m : 0;
            p[r] = (lane < 32) ? part[mm * 32 + lane] : 0.f; mx[r] = (lane < 32) ? pmax[mm * 32 + lane] : 0.f;
            const u32x4* src = (const u32x4*)(XB + mm * D) + lane;
#pragma unroll
            for (int j = 0; j < 4; ++j) v[r][j] = src[64 * j]; }
#pragma unroll
        for (int r = 0; r < NR; ++r) { const int m = m0 + r * NGW; if (m >= M) break;
            const float ps = wave_sum(p[r]); float mxr = mx[r];
#pragma unroll
            for (int of = 1; of < 64; of <<= 1) mxr = fmaxf(mxr, __shfl_xor(mxr, of));
            mxr = fmaxf(mxr, 1e-30f); const float sc = 127.0f / mxr;
            u32x2* dst = (u32x2*)(AQ + (size_t)m * D) + lane;
#pragma unroll
            for (int j = 0; j < 4; ++j) dst[64 * j] = q8x8(v[r][j], sc);
            if (lane == 0) rowfac[m] = __builtin_amdgcn_rsqf(ps * (1.0f / D) + EPS) * mxr * (1.0f / 127.0f); }
    }
}
template <int NP> __device__ __forceinline__ void rs_finalize(const float* part, float* rs, float inv_width, int tid) {
    for (int m = blockIdx.x * NTHREADS + tid; m < M; m += gridDim.x * NTHREADS) { const f32x4* p = (const f32x4*)(part + (size_t)m * NP); float s = 0.f;
#pragma unroll
        for (int j = 0; j < NP / 4; ++j) { const f32x4 v = p[j]; s += (v[0] + v[1]) + (v[2] + v[3]); }
        rs[m] = __builtin_amdgcn_rsqf(s * inv_width + EPS); }
}

constexpr int KS_STRIDE = 144, VT_OFF = 256 * KS_STRIDE, VT_STRIDE = 528, ATT_BUF = VT_OFF + 64 * VT_STRIDE;
static_assert(2 * ATT_BUF <= LDS_BYTES, "two attention staging buffers");
struct AttnKV { u32x4 k[4], va[2], vb[2]; };
__device__ __forceinline__ void attn_load(AttnKV& R, bf16x8 (&q)[8], int au, const bf16_t* Qg, const bf16_t* Kg, const bf16_t* Vg, int tid) {
    const int wid = tid >> 6, lane = tid & 63, fr = lane & 15, fq = lane >> 4;
    const int b = au >> 9, blk = (au >> 2) & 127, kvh = au & 3;
    const int tok0 = b * SEQ + blk * 128;
#pragma unroll
    for (int it = 0; it < 4; ++it) { const int c = it * NTHREADS + tid, key = c >> 3, dc = c & 7;
        u32x4 v = (u32x4){0u, 0u, 0u, 0u};
        if (blk > 0 || key >= 128) v = *(const u32x4*)(Kg + (size_t)(tok0 - 128 + key) * 256 + kvh * 64 + dc * 8);
        R.k[it] = v; }
#pragma unroll
    for (int it = 0; it < 2; ++it) { const int task = it * NTHREADS + tid, p = task & 127, dc = task >> 7, key0 = 2 * p;
        u32x4 a = (u32x4){0u, 0u, 0u, 0u}, bb = a;
        if (blk > 0 || key0 >= 128) { const bf16_t* src = Vg + (size_t)(tok0 - 128 + key0) * 256 + kvh * 64 + dc * 8; a = *(const u32x4*)src; bb = *(const u32x4*)(src + 256); }
        R.va[it] = a; R.vb[it] = bb; }
    const int hq = kvh * 4 + (wid >> 1), i0 = (wid & 1) * 64;
#pragma unroll
    for (int s = 0; s < 4; ++s) { const bf16_t* qp = Qg + (size_t)(tok0 + i0 + 16 * s + fr) * 1024 + hq * 64 + fq * 8; q[2 * s] = *(const bf16x8*)qp; q[2 * s + 1] = *(const bf16x8*)(qp + 32); }
}
__device__ __forceinline__ void attn_store_lds(const AttnKV& R, LAS unsigned char* lds, int tid) {
#pragma unroll
    for (int it = 0; it < 4; ++it) { const int c = it * NTHREADS + tid, key = c >> 3, dc = c & 7; *(LAS u32x4*)(lds + key * KS_STRIDE + dc * 16) = R.k[it]; }
#pragma unroll
    for (int it = 0; it < 2; ++it) { const int task = it * NTHREADS + tid, p = task & 127, dc = task >> 7;
#pragma unroll
        for (int i = 0; i < 4; ++i) { const unsigned wa = R.va[it][i], wb = R.vb[it][i];
            *(LAS unsigned*)(lds + VT_OFF + (dc * 8 + 2 * i) * VT_STRIDE + p * 4) = (wa & 0xffffu) | (wb << 16);
            *(LAS unsigned*)(lds + VT_OFF + (dc * 8 + 2 * i + 1) * VT_STRIDE + p * 4) = (wa >> 16) | (wb & 0xffff0000u); } }
}
__device__ __forceinline__ void attn_compute(LAS unsigned char* lds, int au, const bf16x8 (&q)[8], bf16_t* AO, float* partA, const float sink, int tid) {
    const int wid = __builtin_amdgcn_readfirstlane(tid >> 6), lane = tid & 63, fr = lane & 15, fq = lane >> 4;
    const int b = au >> 9, blk = (au >> 2) & 127, kvh = au & 3;
    const int tok0 = b * SEQ + blk * 128;
    const int g = wid >> 1, i0 = (wid & 1) * 64, hq = kvh * 4 + g;
#pragma unroll
    for (int s = 0; s < 4; ++s) {
        const int qi = i0 + 16 * s + fr;
        const bf16x8 q0 = q[2 * s], q1 = q[2 * s + 1];
        const int T0e = ((i0 >> 4) + s) & ~1;
        f32x4 sc[10];
#pragma unroll
        for (int tt = 0; tt < 10; ++tt) { const int rel = 16 * tt - 16 * (s & 1);
            if (rel < 0 || rel > 128) { sc[tt] = (f32x4){0.f, 0.f, 0.f, 0.f}; continue; }
            const LAS unsigned char* kp = lds + (16 * (T0e + tt) + fr) * KS_STRIDE + fq * 16;
            const bf16x8 k0 = *(const LAS bf16x8*)kp, k1 = *(const LAS bf16x8*)(kp + 64);
            f32x4 a = (f32x4){0.f, 0.f, 0.f, 0.f};
            a = __builtin_amdgcn_mfma_f32_16x16x32_bf16(k0, q0, a, 0, 0, 0); a = __builtin_amdgcn_mfma_f32_16x16x32_bf16(k1, q1, a, 0, 0, 0); sc[tt] = a; }
        float mx = -1e30f;
#pragma unroll
        for (int tt = 0; tt < 10; ++tt) { const int rel = 16 * tt - 16 * (s & 1);
            if (rel < 0 || rel > 128) continue;
            if (rel >= 16 && rel <= 112) { const bool tv = (blk > 0) || (T0e + tt >= 8);
#pragma unroll
                for (int j = 0; j < 4; ++j) { const float v = tv ? sc[tt][j] : -1e30f; sc[tt][j] = v; mx = fmaxf(mx, v); } }
            else {
#pragma unroll
                for (int j = 0; j < 4; ++j) { const int kj = 16 * (T0e + tt) + 4 * fq + j, diff = qi + 128 - kj;
                    const bool valid = (diff >= 0) && (diff < 128) && (blk > 0 || kj >= 128);
                    const float v = valid ? sc[tt][j] : -1e30f; sc[tt][j] = v; mx = fmaxf(mx, v); } } }
        mx = fmaxf(mx, __shfl_xor(mx, 16)); mx = fmaxf(mx, __shfl_xor(mx, 32)); mx = fmaxf(mx, sink);
        float l = 0.f;
#pragma unroll
        for (int tt = 0; tt < 10; ++tt) { const int rel = 16 * tt - 16 * (s & 1);
            if (rel < 0 || rel > 128) continue;
#pragma unroll
            for (int j = 0; j < 4; ++j) { const float p = __builtin_amdgcn_exp2f(sc[tt][j] - mx); sc[tt][j] = p; l += p; } }
        l += __shfl_xor(l, 16); l += __shfl_xor(l, 32); l += __builtin_amdgcn_exp2f(sink - mx);
        f32x4 o[4];
#pragma unroll
        for (int dt = 0; dt < 4; ++dt) o[dt] = (f32x4){0.f, 0.f, 0.f, 0.f};
#pragma unroll
        for (int u = 0; u < 5; ++u) { const u32x4 pw = pg8::pack8(sc[2 * u], sc[2 * u + 1]); const bf16x8 pf = __builtin_bit_cast(bf16x8, pw);
#pragma unroll
            for (int dt = 0; dt < 4; ++dt) { const LAS unsigned char* vp = lds + VT_OFF + (16 * dt + fr) * VT_STRIDE + (16 * (T0e + 2 * u) + 4 * fq) * 2;
                const u32x2 lo = *(const LAS u32x2*)vp, hi = *(const LAS u32x2*)(vp + 32);
                const u32x4 vw = (u32x4){lo.x, lo.y, hi.x, hi.y};
                o[dt] = __builtin_amdgcn_mfma_f32_16x16x32_bf16(__builtin_bit_cast(bf16x8, vw), pf, o[dt], 0, 0, 0); } }
        const float inv = 1.0f / l; float ss = 0.f;
        bf16_t* op = AO + (size_t)(tok0 + qi) * 2048 + hq * 64 + 4 * fq;
#pragma unroll
        for (int dt = 0; dt < 4; ++dt) { const f32x4 v = o[dt] * inv; ss += pg8::dot4(v); u32x2 w; w.x = cvt_pk_bf16(v[0], v[1]); w.y = cvt_pk_bf16(v[2], v[3]); *(u32x2*)(op + 16 * dt) = w; }
        ss += __shfl_xor(ss, 16); ss += __shfl_xor(ss, 32);
        if (fq == 0) partA[(size_t)(tok0 + qi) * 16 + hq] = ss;
    }
}

constexpr int GT_STRIDE = 272, GM_BUF = 128 * GT_STRIDE;
struct GmlpIn { u32x4 a[2], b[2]; f32x4 pa[2], pb[2]; };
__device__ __forceinline__ void gmlp_load(GmlpIn& R, int gu, const bf16_t* GV, const float* partG, int tid) {
    const int b = gu >> 10, chunk = (gu >> 3) & 127, g = gu & 7;
    const int tok0 = b * SEQ + chunk * 128;
#pragma unroll
    for (int it = 0; it < 2; ++it) { const int task = it * NTHREADS + tid, p = task & 63, cc = task >> 6; const int row0 = tok0 + 2 * p;
        const bf16_t* src = GV + (size_t)row0 * 1024 + g * 128 + cc * 8;
        R.a[it] = *(const u32x4*)src; R.b[it] = *(const u32x4*)(src + 1024);
        R.pa[it] = *(const f32x4*)(partG + ((size_t)row0 * 8 + g) * 4); R.pb[it] = *(const f32x4*)(partG + ((size_t)(row0 + 1) * 8 + g) * 4); }
}
__device__ __forceinline__ void gmlp_store_lds(const GmlpIn& R, LAS unsigned char* lds, int tid) {
#pragma unroll
    for (int it = 0; it < 2; ++it) { const int task = it * NTHREADS + tid, p = task & 63, cc = task >> 6;
        const f32x4 pa = R.pa[it], pb = R.pb[it];
        const float rsa = __builtin_amdgcn_rsqf(((pa[0] + pa[1]) + (pa[2] + pa[3])) * (1.0f / 128.0f) + EPS), rsb = __builtin_amdgcn_rsqf(((pb[0] + pb[1]) + (pb[2] + pb[3])) * (1.0f / 128.0f) + EPS);
#pragma unroll
        for (int i = 0; i < 4; ++i) { const unsigned wa = R.a[it][i], wb = R.b[it][i];
            *(LAS unsigned*)(lds + (cc * 8 + 2 * i) * GT_STRIDE + p * 4) = cvt_pk_bf16(bf2f(wa & 0xffffu) * rsa, bf2f(wb & 0xffffu) * rsb);
            *(LAS unsigned*)(lds + (cc * 8 + 2 * i + 1) * GT_STRIDE + p * 4) = cvt_pk_bf16(bf2f(wa >> 16) * rsa, bf2f(wb >> 16) * rsb); } }
}
struct GmlpCur { u32x2 gw[8]; bf16x8 wf[4]; float bias; };
__device__ __forceinline__ void gmlp_cur_load(GmlpCur& C, int gu, const bf16_t* GU, const bf16_t* WSB, const float* bsp, int tid) {
    const int wid = tid >> 6, lane = tid & 63, fr = lane & 15, fq = lane >> 4;
    const int b = gu >> 10, chunk = (gu >> 3) & 127, g = gu & 7;
    const int t = 16 * wid + fr, row = b * SEQ + chunk * 128 + t;
#pragma unroll
    for (int ks = 0; ks < 4; ++ks) C.wf[ks] = *(const bf16x8*)(WSB + (size_t)(g * 128 + t) * 128 + 32 * ks + 8 * fq);
#pragma unroll
    for (int ct = 0; ct < 8; ++ct) C.gw[ct] = *(const u32x2*)(GU + (size_t)row * 1024 + g * 128 + 16 * ct + 4 * fq);
    C.bias = bsp[g * 128 + t];
}
__device__ __forceinline__ void gmlp_compute(LAS unsigned char* lds, int gu, const GmlpCur& C, bf16_t* AO, float* partB, int tid) {
    const int wid = __builtin_amdgcn_readfirstlane(tid >> 6), lane = tid & 63, fr = lane & 15, fq = lane >> 4;
    const int b = gu >> 10, chunk = (gu >> 3) & 127, g = gu & 7;
    const int tok0 = b * SEQ + chunk * 128;
    const int t = 16 * wid + fr, nks = (wid >> 1) + 1, row = tok0 + t;
    const float bias = C.bias;
    f32x4 acc[8];
#pragma unroll
    for (int ct = 0; ct < 8; ++ct) acc[ct] = (f32x4){0.f, 0.f, 0.f, 0.f};
#pragma unroll
    for (int ks = 0; ks < 4; ++ks) if (ks < nks) {
#pragma unroll
        for (int ct = 0; ct < 8; ++ct) { const bf16x8 af = *(const LAS bf16x8*)(lds + (16 * ct + fr) * GT_STRIDE + (32 * ks + 8 * fq) * 2);
            acc[ct] = __builtin_amdgcn_mfma_f32_16x16x32_bf16(af, C.wf[ks], acc[ct], 0, 0, 0); } }
    float ss = 0.f;
#pragma unroll
    for (int ct = 0; ct < 8; ++ct) { const int col = g * 128 + 16 * ct + 4 * fq; const u32x2 gw = C.gw[ct];
        f32x4 v; v[0] = bf2f(gw.x & 0xffffu) * (acc[ct][0] + bias); v[1] = bf2f(gw.x >> 16) * (acc[ct][1] + bias); v[2] = bf2f(gw.y & 0xffffu) * (acc[ct][2] + bias); v[3] = bf2f(gw.y >> 16) * (acc[ct][3] + bias);
        ss += pg8::dot4(v); u32x2 w; w.x = cvt_pk_bf16(v[0], v[1]); w.y = cvt_pk_bf16(v[2], v[3]);
        *(u32x2*)(AO + (size_t)row * 2048 + 1024 + col) = w; }
    ss += __shfl_xor(ss, 16); ss += __shfl_xor(ss, 32);
    if (fq == 0) partB[(size_t)row * 8 + g] = ss;
}

__device__ __forceinline__ void mixer_phase(LAS unsigned char* lds, unsigned char* ws, const float* sinks, const float* bsp, int tid) {
    const int G = gridDim.x;
    const bf16_t* Qg = (const bf16_t*)(ws + WS_Q); const bf16_t* Kg = (const bf16_t*)(ws + WS_K); const bf16_t* Vg = (const bf16_t*)(ws + WS_V);
    const bf16_t* GU = (const bf16_t*)(ws + WS_GU); const bf16_t* GV = (const bf16_t*)(ws + WS_GV); const bf16_t* WSB = (const bf16_t*)(ws + WS_WSB);
    bf16_t* AO = (bf16_t*)(ws + WS_AO); float* partA = (float*)(ws + WS_PARTA); float* partB = (float*)(ws + WS_PARTB); const float* partG = (const float*)(ws + WS_PARTG);
    {
        constexpr int NA = BATCH * 128 * 4;
        int au = blockIdx.x, par = 0; AttnKV R; bf16x8 q[8], qn[8];
        if (au < NA) { attn_load(R, q, au, Qg, Kg, Vg, tid); attn_store_lds(R, lds, tid); }
        __syncthreads();
        for (; au < NA; au += G) { const int an = au + G; const bool hn = an < NA;
#pragma unroll
            for (int i = 0; i < 8; ++i) qn[i] = q[i];
            const float sink = sinks[(au & 3) * 4 + (__builtin_amdgcn_readfirstlane(tid >> 6) >> 1)] * 1.4426950408889634f;
            asm volatile("" :: "v"(sink));
            if (hn) attn_load(R, qn, an, Qg, Kg, Vg, tid);
            attn_compute(lds + par * ATT_BUF, au, q, AO, partA, sink, tid);
            if (hn) attn_store_lds(R, lds + (par ^ 1) * ATT_BUF, tid);
            __syncthreads();
#pragma unroll
            for (int i = 0; i < 8; ++i) q[i] = qn[i];
            par ^= 1; }
    }
    {
        constexpr int NG = BATCH * 128 * 8;
        int gu = blockIdx.x, par = 0; GmlpIn R;
        if (gu < NG) { gmlp_load(R, gu, GV, partG, tid); gmlp_store_lds(R, lds, tid); }
        __syncthreads();
        for (; gu < NG; gu += G) { const int gn = gu + G; const bool hn = gn < NG;
            GmlpCur C; gmlp_cur_load(C, gu, GU, WSB, bsp, tid);
            if (hn) gmlp_load(R, gn, GV, partG, tid);
            gmlp_compute(lds + par * GM_BUF, gu, C, AO, partB, tid);
            if (hn) gmlp_store_lds(R, lds + (par ^ 1) * GM_BUF, tid);
            __syncthreads();
            par ^= 1; }
    }
}

#define XB_TMO      128
#define XB_XCNT(j)  (256  + 64 * (j))
#define XB_XSUB(j)  (1280 + 64 * (j))
#define XB_XGEN(j)  (2304 + 64 * (j))
#define XB_TOP      3328
#define XB_TOPGEN   3392
#define XCD_BAR_WORDS 3456
#define XB_SPIN_CAP (1u << 18)

__device__ __forceinline__ unsigned xb_ld(unsigned* p)              { return __hip_atomic_load(p, __ATOMIC_RELAXED, __HIP_MEMORY_SCOPE_AGENT); }
__device__ __forceinline__ unsigned xb_add(unsigned* p, unsigned v) { return __hip_atomic_fetch_add(p, v, __ATOMIC_RELAXED, __HIP_MEMORY_SCOPE_AGENT); }
__device__ __forceinline__ unsigned xb_xcc_id() { return (unsigned)__builtin_amdgcn_s_getreg((3 << 11) | 20) & 0xFu; }
#define XB_SPIN(cond, bar) do { unsigned _sp = 0; while (cond) { __builtin_amdgcn_s_sleep(1); \
    if ((++_sp & 255u) == 0u) { if (xb_ld(&(bar)[XB_TMO])) break; if (_sp > XB_SPIN_CAP) { atomicAdd(&(bar)[XB_TMO], 1u); break; } } } } while (0)

struct XcdBarrier {
    unsigned* bar; unsigned x;
    volatile LAS unsigned* st;
};

__device__ __forceinline__ XcdBarrier xcd_barrier_post(unsigned* bar, volatile LAS unsigned* st) {
    XcdBarrier b; b.bar = bar; b.x = xb_xcc_id(); b.st = st;
    if (threadIdx.x == 0) (void)xb_add(&bar[XB_XCNT(b.x)], 1u);
    return b;
}
__device__ __forceinline__ void xcd_barrier_complete(unsigned* bar, unsigned x, unsigned& nloc, unsigned& nx) {
    const unsigned G = gridDim.x * gridDim.y * gridDim.z;
    unsigned sum, cnt, mine, sp = 0u;
    for (;;) {
        sum = 0u; cnt = 0u; mine = 0u;
#pragma unroll
        for (unsigned j = 0; j < 16; ++j) { const unsigned c = xb_ld(&bar[XB_XCNT(j)]); sum += c; cnt += (c > 0u) ? 1u : 0u; mine = (j == x) ? c : mine; }
        if (sum == G) break;
        __builtin_amdgcn_s_sleep(1);
        if ((++sp & 255u) == 0u) { if (xb_ld(&bar[XB_TMO])) break; if (sp > XB_SPIN_CAP) { atomicAdd(&bar[XB_TMO], 1u); break; } }
    }
    nloc = mine > 0u ? mine : 1u; nx = cnt > 0u ? cnt : 1u;
}

__device__ __forceinline__ void xcd_barrier(const XcdBarrier& b) {
    asm volatile("s_waitcnt vmcnt(0)" ::: "memory");
    __syncthreads();
    if (threadIdx.x == 0) {
        unsigned* bar = b.bar;
        __builtin_amdgcn_s_waitcnt(0);
        unsigned nloc = b.st[0], nx = b.st[1];
        if (nloc == 0u) { xcd_barrier_complete(bar, b.x, nloc, nx); b.st[0] = nloc; b.st[1] = nx; }
        const unsigned old = xb_add(&bar[XB_XSUB(b.x)], 1u);
        const unsigned gen = old / nloc;
        if (old + 1u == (gen + 1u) * nloc) {
            __builtin_amdgcn_fence(__ATOMIC_RELEASE, "agent");
            asm volatile("s_waitcnt vmcnt(0)" ::: "memory");
            const unsigned og = xb_add(&bar[XB_TOP], 1u);
            const unsigned tg = og / nx;
            if (og + 1u == (tg + 1u) * nx) xb_add(&bar[XB_TOPGEN], 1u);
            else XB_SPIN(xb_ld(&bar[XB_TOPGEN]) == tg, bar);
            __builtin_amdgcn_fence(__ATOMIC_ACQUIRE, "agent");
            xb_add(&bar[XB_XGEN(b.x)], 1u);
            asm volatile("s_waitcnt vmcnt(0)" ::: "memory");
        } else {
            XB_SPIN(xb_ld(&bar[XB_XGEN(b.x)]) == gen, bar);
            __builtin_amdgcn_fence(__ATOMIC_ACQUIRE, "agent");
            asm volatile("s_waitcnt vmcnt(0)" ::: "memory");
        }
    }
    __syncthreads();
}

#ifndef MK_SPLIT
#define MK_SPLIT 0
#endif
#define NPHASE 11
#ifndef MK_PROBE_HI1
#define MK_PROBE_HI1 NPHASE
#define MK_PROBE_LO2 0
#endif
__global__ void __launch_bounds__(NTHREADS, 2) hymba_fwd(Args A) {
    extern __shared__ __attribute__((aligned(16))) unsigned char lds_raw[];
    LAS unsigned char* lds = (LAS unsigned char*)lds_raw;
    cg::grid_group grid = cg::this_grid();
    const int tid = threadIdx.x, G = gridDim.x, lo = A.ph_lo, hi = A.ph_hi;
    unsigned char* ws = A.ws;
    float* rsb = (float*)(ws + WS_RS); float *rs1 = rsb, *rs2 = rsb + M, *rsA = rsb + 2 * M, *rsB = rsb + 3 * M, *rs3 = rsb + 4 * M;
    bf16_t* XB = (bf16_t*)(ws + WS_XB); bf16_t* H = (bf16_t*)(ws + WS_H); bf16_t* AO = (bf16_t*)(ws + WS_AO);
    float* part = (float*)(ws + WS_PART); float* partA = (float*)(ws + WS_PARTA); float* partB = (float*)(ws + WS_PARTB); float* partG = (float*)(ws + WS_PARTG);
#define IN(k) (lo <= (k) && (k) < hi)
    volatile LAS unsigned* bst = (volatile LAS unsigned*)(lds + LDS_BYTES - 16);
    if (tid < 4) bst[tid] = 0u;
    __syncthreads();
    const XcdBarrier bar = xcd_barrier_post((unsigned*)(ws + WS_BAR), bst);
#define SEAM(k) do { if (IN(k) && IN((k) + 1)) xcd_barrier(bar); } while (0)
    if (lo < 0) grid.sync();
    if (IN(0)) { p0_prologue(A, lds, tid); __syncthreads(); xcd_barrier(bar);
        quantize_wgu(ws + WS_WGU1, ws + WS_WGU1Q, (const unsigned*)(ws + WS_CMAX1), tid); quantize_wgu(ws + WS_WGU2, ws + WS_WGU2Q, (const unsigned*)(ws + WS_CMAX2), tid); }
    SEAM(0);
    if (IN(1)) {
        pg8::Gemm g{(const bf16_t*)(ws + WS_AQ), (const bf16_t*)(ws + WS_WGU1Q), M, NGU, D / 2}; pg8::StaticOrder S; S.init(M, NGU, G, (int)blockIdx.x);
        pg8::EpiSwiglu<false, true> E{H, rs1, FF, 1.0f, (const unsigned*)(ws + WS_CMAX1)};
        pg8::gemm_phase<pg8::EpiSwiglu<false, true>, pg8::StaticOrder, true, true, 0, 2>(lds, g, S, E);
    }
    SEAM(1);
    if (IN(2)) {
        pg8::Gemm g{H, (const bf16_t*)(ws + WS_WD1), M, D, FF}; pg8::StaticOrder S; S.init(M, D, G, (int)blockIdx.x);
        pg8::EpiResid<false, true, false> E{A.out, XB, part, nullptr, nullptr, 0.5f, nullptr};
        pg8::gemm_phase<pg8::EpiResid<false, true, false>, pg8::StaticOrder, true, true>(lds, g, S, E);
    }
    SEAM(2);
#define MY_PANELS(S_, ...) do { int prev_ = -1; pg8::Unit u_; for (int i_ = 0; (S_).next(i_, u_); ++i_) if (u_.pm != prev_) { prev_ = u_.pm; if (tid < 256) { const int m = u_.pm * 256 + tid; __VA_ARGS__ } } asm volatile("s_waitcnt vmcnt(0)" ::: "memory"); __syncthreads(); } while (0)
    if (IN(4)) {
        pg8::Gemm g{XB, (const bf16_t*)(ws + WS_WIN), M, NIN, D}; pg8::StaticOrder S; S.init(M, NIN, G, (int)blockIdx.x);
        MY_PANELS(S, { const f32x4* p = (const f32x4*)(part + (size_t)m * 32); float sm = 0.f;
            for (int j = 0; j < 8; ++j) { const f32x4 v = p[j]; sm += (v[0] + v[1]) + (v[2] + v[3]); }
            rs2[m] = __builtin_amdgcn_rsqf(sm * (1.0f / D) + EPS); });
        pg8::EpiIn E{(bf16_t*)(ws + WS_Q), (bf16_t*)(ws + WS_K), (bf16_t*)(ws + WS_V), (bf16_t*)(ws + WS_GU), (bf16_t*)(ws + WS_GV), rs2,
                     (const float*)A.in[8], (const float*)A.in[9], (const float*)A.in[11], (const float*)(ws + WS_CS), partG};
        pg8::gemm_phase<pg8::EpiIn, pg8::StaticOrder, true, true>(lds, g, S, E);
    }
    SEAM(4);
    if (IN(5)) mixer_phase(lds, ws, (const float*)A.in[10], (const float*)A.in[13], tid);
    SEAM(5);
    if (IN(7)) {
        pg8::Gemm g{AO, (const bf16_t*)(ws + WS_WOUT), M, D, D}; pg8::StaticOrder S; S.init(M, D, G, (int)blockIdx.x);
        MY_PANELS(S, { const f32x4* pa = (const f32x4*)(partA + (size_t)m * 16); const f32x4* pb = (const f32x4*)(partB + (size_t)m * 8); float sa = 0.f, sb = 0.f;
            for (int j = 0; j < 4; ++j) { const f32x4 v = pa[j]; sa += (v[0] + v[1]) + (v[2] + v[3]); }
            for (int j = 0; j < 2; ++j) { const f32x4 v = pb[j]; sb += (v[0] + v[1]) + (v[2] + v[3]); }
            const float ra = __builtin_amdgcn_rsqf(sa * (1.0f / 1024.0f) + EPS), rb = __builtin_amdgcn_rsqf(sb * (1.0f / 1024.0f) + EPS);
            rsA[m] = ra / rb; rsB[m] = rb; });
        pg8::EpiResid<true, true, false> E{A.out, XB, part, rsA, rsB, 0.f, (float*)(ws + WS_PMAX)};
        pg8::gemm_phase<pg8::EpiResid<true, true, false>, pg8::StaticOrder, true, true, 1024>(lds, g, S, E);
    }
    SEAM(7);
    if (IN(8)) quantize_x2(ws, part, rs3, tid);
    SEAM(8);
    if (IN(9)) {
        pg8::Gemm g{(const bf16_t*)(ws + WS_AQ), (const bf16_t*)(ws + WS_WGU2Q), M, NGU, D / 2}; pg8::StaticOrder S; S.init(M, NGU, G, (int)blockIdx.x);
        pg8::EpiSwiglu<true, true> E{H, rs3, FF, 4.0f, (const unsigned*)(ws + WS_CMAX2)};
        pg8::gemm_phase<pg8::EpiSwiglu<true, true>, pg8::StaticOrder, true, true, 0, 2>(lds, g, S, E);
    }
    SEAM(9);
    if (IN(10)) {
        pg8::Gemm g{H, (const bf16_t*)(ws + WS_WD2), M, D, FF / 2}; pg8::StaticOrder S; S.init(M, D, G, (int)blockIdx.x);
        pg8::EpiResid<false, false, true> E{A.out, XB, nullptr, nullptr, nullptr, 0.5f / (64.0f * 4.0f), nullptr};
        pg8::gemm_phase<pg8::EpiResid<false, false, true>, pg8::StaticOrder, true, true, 0, 1>(lds, g, S, E);
    }
#undef IN
#undef SEAM
}

extern "C" void kernel_launch(void* const* d_in, const int* in_sizes, int n_in, void* d_out, int out_size, void* d_ws, size_t ws_size, hipStream_t stream) {
    static int grid = 0;
    if (grid == 0) {
        if (n_in != 21 || in_sizes[0] != M * D || out_size != M * D || ws_size < WS_END) { fprintf(stderr, "kernel_launch: unexpected shapes (n_in %d, in0 %d, out %d, ws %zu); nothing launched\n", n_in, n_in > 0 ? in_sizes[0] : -1, out_size, ws_size); grid = -1; return; }
        int dev = 0, cus = 0, per_cu = 0;
        if (hipGetDevice(&dev) != hipSuccess || hipDeviceGetAttribute(&cus, hipDeviceAttributeMultiprocessorCount, dev) != hipSuccess) { grid = -1; return; }
        if (hipFuncSetAttribute((const void*)hymba_fwd, hipFuncAttributeMaxDynamicSharedMemorySize, LDS_BYTES) != hipSuccess) { fprintf(stderr, "kernel_launch: hipFuncSetAttribute failed\n"); grid = -1; return; }
        if (hipOccupancyMaxActiveBlocksPerMultiprocessor(&per_cu, (const void*)hymba_fwd, NTHREADS, LDS_BYTES) != hipSuccess || per_cu < 1) per_cu = 1;
        (void)hipGetLastError();
        grid = cus * per_cu;
    }
    if (grid < 0) return;
    if (hipMemsetAsync((char*)d_ws + WS_BAR, 0, CTL_ZERO_BYTES, stream) != hipSuccess) { fprintf(stderr, "kernel_launch: hipMemsetAsync failed\n"); return; }
    Args a{};
    for (int i = 0; i < 21; ++i) a.in[i] = d_in[i];
    a.out = (float*)d_out; a.ws = (unsigned char*)d_ws;
    void* args[] = {&a};
    a.ph_lo = 0; a.ph_hi = NPHASE;
    hipError_t e = hipLaunchCooperativeKernel((const void*)hymba_fwd, dim3(grid), dim3(NTHREADS), args, LDS_BYTES, stream);
    if (e != hipSuccess) fprintf(stderr, "kernel_launch: cooperative launch failed: %s (grid %d)\n", hipGetErrorString(e), grid);
}
```

```cpp
#include <hip/hip_runtime.h>
#include <hip/hip_cooperative_groups.h>
#include <cstdio>
#include <cstdint>
namespace cg = cooperative_groups;
namespace pg8 {
#define PG8_LAS __attribute__((address_space(3)))
typedef unsigned short bf16_t;
typedef short bf16x8 __attribute__((ext_vector_type(8)));
typedef float f32x4 __attribute__((ext_vector_type(4)));
typedef unsigned u32x4 __attribute__((ext_vector_type(4)));
constexpr int BM = 256, BK = 64, HALF = 128, HTB = HALF * BK * 2  , STAGE_BYTES = 8 * HTB, NXCD = 8, WGM = 8;

__host__ __device__ __forceinline__ int lds_byte(int r, int c) { const int st = (r >> 4) * 2 + (c >> 5), rr = r & 15, cc = c & 31, ob = rr * 64 + cc * 2; return st * 1024 + (ob ^ (((ob >> 9) & 1) << 5)); }
__host__ __device__ __forceinline__ void stage_rc(int b, int& R, int& C) { const int st = b / 1024, sb = b % 1024, swz = sb ^ (((sb >> 9) & 1) << 5); R = (st >> 1) * 16 + swz / 64; C = (st & 1) * 32 + (swz % 64) / 2; }
__host__ __device__ __forceinline__ int perm32(int rho) { const int n = rho >> 4, i = rho & 15; return 8 * (i >> 2) + 4 * n + (i & 3); }

struct Unit { int pm, pn; };
struct Gemm { const bf16_t* A; const bf16_t* Bt; int M, N, K; };

struct StaticOrder {
    int nM, nN, nwg, G, c;
    __host__ __device__ void init(int M, int N, int G_, int c_) { nM = M / BM; nN = N / BM; nwg = nM * nN; G = G_; c = c_; }
    __host__ __device__ bool next(int i, Unit& u) const {
        const long L = (long)i * G + c; if (L >= nwg) return false;
        int wgid = (int)L; { const int q = nwg / NXCD, r = nwg % NXCD, xcd = wgid % NXCD, off = wgid / NXCD; wgid = (xcd < r ? xcd * (q + 1) : r * (q + 1) + (xcd - r) * q) + off; }
        const int nig = WGM * nN, gid = wgid / nig, fm = gid * WGM, gsz = (nM - fm) < WGM ? (nM - fm) : WGM;
        u.pm = fm + ((wgid % nig) % gsz); u.pn = (wgid % nig) / gsz; return true;
    }
    __device__ __forceinline__ void a_ready(const Unit&) const {}
    __device__ __forceinline__ void done(const Unit&) const {}
};
__device__ __forceinline__ unsigned cvt_pk_bf16(float lo, float hi) { unsigned r; asm volatile("v_cvt_pk_bf16_f32 %0, %1, %2" : "=v"(r) : "v"(lo), "v"(hi)); return r; }
typedef unsigned u32x2 __attribute__((ext_vector_type(2)));
typedef int i32x8 __attribute__((ext_vector_type(8)));
typedef int i32x4 __attribute__((ext_vector_type(4)));
__device__ __forceinline__ i32x8 cat8(const bf16x8 a, const bf16x8 b) { const i32x4 x = __builtin_bit_cast(i32x4, a), y = __builtin_bit_cast(i32x4, b); return __builtin_shufflevector(x, y, 0, 1, 2, 3, 4, 5, 6, 7); }
__device__ __forceinline__ float clamp448(float v) { return __builtin_amdgcn_fmed3f(v, -448.0f, 448.0f); }
__device__ __forceinline__ unsigned pack4_fp8(const f32x4 v) { int w = __builtin_amdgcn_cvt_pk_fp8_f32(clamp448(v[0]), clamp448(v[1]), 0, false); w = __builtin_amdgcn_cvt_pk_fp8_f32(clamp448(v[2]), clamp448(v[3]), w, true); return (unsigned)w; }
__device__ __forceinline__ float fast_rcp(float x) { return __builtin_amdgcn_rcpf(x); }
__device__ __forceinline__ float fast_exp(float x) { return __builtin_amdgcn_exp2f(x * 1.4426950408889634f); }
__device__ __forceinline__ float silu_f(float g) { return g * fast_rcp(1.0f + fast_exp(-g)); }
__device__ __forceinline__ float gelu_t(float x) { const float u = 0.7978845608028654f * (x + 0.044715f * x * x * x); return x * fast_rcp(1.0f + fast_exp(-2.0f * u)); }
__device__ __forceinline__ u32x4 pack8(const f32x4 a, const f32x4 b) { u32x4 w; w.x = cvt_pk_bf16(a[0], a[1]); w.y = cvt_pk_bf16(a[2], a[3]); w.z = cvt_pk_bf16(b[0], b[1]); w.w = cvt_pk_bf16(b[2], b[3]); return w; }
__device__ __forceinline__ float dot4(const f32x4 a) { return (a[0] * a[0] + a[1] * a[1]) + (a[2] * a[2] + a[3] * a[3]); }

template <bool F8OUT, bool I8IN = false> struct EpiSwiglu {
    static constexpr bool PERM = true, AFTER_DRAIN = false;
    bf16_t* H; const float* rs; int ldh; float hscale; const unsigned* colmax;
    __device__ __forceinline__ void mid(f32x4 (&)[2][2][4][2], const Unit&, int, int, int, int) const {}
    __device__ __forceinline__ void pre(float (&p)[8], const Unit& u, int wr, int fr) const {
#pragma unroll
        for (int i = 0; i < 8; ++i) p[i] = rs[u.pm * BM + wr * 64 + fr + (i >> 2) * HALF + (i & 3) * 16];
    }
    __device__ __forceinline__ void operator()(const f32x4 (&acc)[2][2][4][2], const Unit& u, int wr, int wc, int fr, int fq, const float (&pr)[8]) const {
        const int row0 = u.pm * BM + wr * 64 + fr, col0 = u.pn * 128 + wc * 32 + 8 * fq;
        f32x4 csg[2], csu[2];
        if constexpr (I8IN) {
#pragma unroll
            for (int n = 0; n < 2; ++n) { const u32x4 a = *(const u32x4*)(colmax + u.pn * BM + wc * 32 + 8 * fq + 4 * n), b = *(const u32x4*)(colmax + u.pn * BM + HALF + wc * 32 + 8 * fq + 4 * n);
                csg[n] = (f32x4){__uint_as_float(a.x), __uint_as_float(a.y), __uint_as_float(a.z), __uint_as_float(a.w)} * (1.0f / 127.0f);
                csu[n] = (f32x4){__uint_as_float(b.x), __uint_as_float(b.y), __uint_as_float(b.z), __uint_as_float(b.w)} * (1.0f / 127.0f); }
        }
#pragma unroll
        for (int ai = 0; ai < 2; ++ai)
#pragma unroll
            for (int m = 0; m < 4; ++m) { const int row = row0 + ai * HALF + m * 16; const float s = pr[ai * 4 + m];
                f32x4 h[2];
#pragma unroll
                for (int n = 0; n < 2; ++n) { f32x4 g, uu;
                    if constexpr (I8IN) { const i32x4 gi = __builtin_bit_cast(i32x4, acc[ai][0][m][n]), ui = __builtin_bit_cast(i32x4, acc[ai][1][m][n]);
                        g = (f32x4){(float)gi[0], (float)gi[1], (float)gi[2], (float)gi[3]} * (csg[n] * s); uu = (f32x4){(float)ui[0], (float)ui[1], (float)ui[2], (float)ui[3]} * (csu[n] * s); }
                    else { g = acc[ai][0][m][n] * s; uu = acc[ai][1][m][n] * s; }
#pragma unroll
                    for (int j = 0; j < 4; ++j) h[n][j] = silu_f(g[j]) * uu[j]; }
                if constexpr (F8OUT) { u32x2 w; w.x = pack4_fp8(h[0] * hscale); w.y = pack4_fp8(h[1] * hscale); *(u32x2*)((unsigned char*)H + (size_t)row * ldh + col0) = w; }
                else *(u32x4*)(H + (size_t)row * ldh + col0) = pack8(h[0], h[1]); }
    }
};

__device__ __forceinline__ f32x4 bflo(const u32x4 w) { return (f32x4){__uint_as_float(w.x << 16), __uint_as_float(w.x & 0xffff0000u), __uint_as_float(w.y << 16), __uint_as_float(w.y & 0xffff0000u)}; }
__device__ __forceinline__ f32x4 bfhi(const u32x4 w) { return (f32x4){__uint_as_float(w.z << 16), __uint_as_float(w.z & 0xffff0000u), __uint_as_float(w.w << 16), __uint_as_float(w.w & 0xffff0000u)}; }
template <bool ROWSCALE, bool WB, bool WF> struct EpiResid {
    static constexpr bool PERM = true, AFTER_DRAIN = false;
    float* out; bf16_t* xb; float* part; const float* rsA; const float* rsB; float alpha; float* partmax;
    __device__ __forceinline__ void pre(float (&p)[8], const Unit& u, int wr, int fr) const {
        if constexpr (ROWSCALE) {
#pragma unroll
            for (int i = 0; i < 8; ++i) p[i] = rsB[u.pm * BM + wr * 64 + fr + (i >> 2) * HALF + (i & 3) * 16];
        }
    }
    __device__ __forceinline__ void mid(f32x4 (&acc)[2][2][4][2], const Unit& u, int wr, int wc, int fr, int fq) const {
        if constexpr (ROWSCALE) {
            const int row0 = u.pm * BM + wr * 64 + fr; float r[8];
#pragma unroll
            for (int i = 0; i < 8; ++i) r[i] = rsA[row0 + (i >> 2) * HALF + (i & 3) * 16];
#pragma unroll
            for (int ai = 0; ai < 2; ++ai)
#pragma unroll
                for (int m = 0; m < 4; ++m)
#pragma unroll
                    for (int bj = 0; bj < 2; ++bj)
#pragma unroll
                        for (int n = 0; n < 2; ++n) acc[ai][bj][m][n] = acc[ai][bj][m][n] * r[ai * 4 + m];
        }
    }
    __device__ __forceinline__ void operator()(const f32x4 (&acc)[2][2][4][2], const Unit& u, int wr, int wc, int fr, int fq, const float (&pr)[8]) const {
        int row0 = u.pm * BM + wr * 64 + fr, col0 = u.pn * BM + wc * 32 + 8 * fq;
        asm volatile("" : "+v"(row0), "+v"(col0));
        constexpr int DEPTH = 8;
        u32x4 rb[16];
#pragma unroll
        for (int st = 0; st < DEPTH; ++st) rb[st] = *(const u32x4*)(xb + (size_t)(row0 + (st >> 3) * HALF + ((st >> 1) & 3) * 16) * 2048 + col0 + (st & 1) * HALF);
        float ss = 0.f, mxv = 0.f;
#pragma unroll
        for (int st = 0; st < 16; ++st) { const int ai = st >> 3, m = (st >> 1) & 3, bj = st & 1; const int row = row0 + ai * HALF + m * 16;
            float a = alpha; if constexpr (ROWSCALE) a = pr[ai * 4 + m];
            const size_t off = (size_t)row * 2048 + col0 + bj * HALF;
            const f32x4 v0 = bflo(rb[st]) + acc[ai][bj][m][0] * a, v1 = bfhi(rb[st]) + acc[ai][bj][m][1] * a;
            if constexpr (WF) { *(f32x4*)(out + off) = v0; *(f32x4*)(out + off + 4) = v1; }
            if constexpr (WB) { *(u32x4*)(xb + off) = pack8(v0, v1); ss += dot4(v0) + dot4(v1);
                if constexpr (ROWSCALE) { const f32x4 a0 = __builtin_elementwise_abs(v0), a1 = __builtin_elementwise_abs(v1); mxv = fmaxf(mxv, fmaxf(fmaxf(fmaxf(a0[0], a0[1]), fmaxf(a0[2], a0[3])), fmaxf(fmaxf(a1[0], a1[1]), fmaxf(a1[2], a1[3])))); }
                if (bj == 1) { ss += __shfl_xor(ss, 16); ss += __shfl_xor(ss, 32); if (fq == 0) part[(size_t)row * 32 + u.pn * 4 + wc] = ss; ss = 0.f;
                    if constexpr (ROWSCALE) { mxv = fmaxf(mxv, __shfl_xor(mxv, 16)); mxv = fmaxf(mxv, __shfl_xor(mxv, 32)); if (fq == 0) partmax[(size_t)row * 32 + u.pn * 4 + wc] = mxv; mxv = 0.f; } } }
            if (st + DEPTH < 16) { const int s2 = st + DEPTH; rb[s2] = *(const u32x4*)(xb + (size_t)(row0 + (s2 >> 3) * HALF + ((s2 >> 1) & 3) * 16) * 2048 + col0 + (s2 & 1) * HALF); } }
    }
};

struct EpiIn {
    static constexpr bool PERM = true, AFTER_DRAIN = false;
    bf16_t *Q, *Kb, *Vb, *GU, *GV; const float *rs2, *qn, *kn, *gvn, *cs; float* partG;
    __device__ __forceinline__ void mid(f32x4 (&)[2][2][4][2], const Unit&, int, int, int, int) const {}
    __device__ __forceinline__ void pre(float (&p)[8], const Unit& u, int wr, int fr) const {
#pragma unroll
        for (int i = 0; i < 8; ++i) p[i] = rs2[u.pm * BM + wr * 64 + fr + (i >> 2) * HALF + (i & 3) * 16];
    }
    __device__ __forceinline__ void operator()(const f32x4 (&acc)[2][2][4][2], const Unit& u, int wr, int wc, int fr, int fq, const float (&pr)[8]) const {
        const int row0 = u.pm * BM + wr * 64 + fr, pn = u.pn;
        if (pn <= 4) {
            const bool isq = pn < 4; const float* gn = isq ? qn : kn; const float osc = isq ? 0.125f * 1.4426950408889634f : 1.0f;
            bf16_t* dst = isq ? (Q + (pn * 4 + wc) * 64 + 16 * fq) : (Kb + wc * 64 + 16 * fq); const int ld = isq ? 1024 : 256;
            f32x4 gg[2][2];
#pragma unroll
            for (int bj = 0; bj < 2; ++bj)
#pragma unroll
                for (int n = 0; n < 2; ++n) gg[bj][n] = *(const f32x4*)(gn + 16 * fq + 8 * n + 4 * bj) * osc;
            f32x4 ccur[4];
#pragma unroll
            for (int q = 0; q < 4; ++q) ccur[q] = *(const f32x4*)(cs + (size_t)row0 * 16 + 4 * q);
#pragma unroll
            for (int ai = 0; ai < 2; ++ai)
#pragma unroll
                for (int m = 0; m < 4; ++m) { const int row = row0 + ai * HALF + m * 16; const float s = pr[ai * 4 + m];
                    f32x4 cnx[4];
#pragma unroll
                    for (int q = 0; q < 4; ++q) cnx[q] = ccur[q];
                    if (ai * 4 + m + 1 < 8) { const int i2 = ai * 4 + m + 1; const float* csn = cs + (size_t)(row0 + (i2 >> 2) * HALF + (i2 & 3) * 16) * 16;
#pragma unroll
                        for (int q = 0; q < 4; ++q) cnx[q] = *(const f32x4*)(csn + 4 * q); }
                    f32x4 v[2][2]; float ss = 0.f;
#pragma unroll
                    for (int bj = 0; bj < 2; ++bj)
#pragma unroll
                        for (int n = 0; n < 2; ++n) { v[bj][n] = acc[ai][bj][m][n] * s; ss += dot4(v[bj][n]); }
                    ss += __shfl_xor(ss, 16); ss += __shfl_xor(ss, 32);
                    const float rn = __builtin_amdgcn_rsqf(ss * (1.0f / 64.0f) + 1e-6f);
#pragma unroll
                    for (int bj = 0; bj < 2; ++bj)
#pragma unroll
                        for (int n = 0; n < 2; ++n) v[bj][n] = v[bj][n] * rn * gg[bj][n];
#pragma unroll
                    for (int bj = 0; bj < 2; ++bj) { const f32x4 cc = ccur[bj], sn = ccur[2 + bj];
                        const f32x4 x1 = v[bj][0], x2 = v[bj][1]; const f32x4 r1 = x1 * cc - x2 * sn, r2 = x2 * cc + x1 * sn;
                        if (fq == 0) { v[bj][0] = r1; v[bj][1] = r2; } }
                    bf16_t* p = dst + (size_t)row * ld;
                    *(u32x4*)p = pack8(v[0][0], v[1][0]); *(u32x4*)(p + 8) = pack8(v[0][1], v[1][1]);
#pragma unroll
                    for (int q = 0; q < 4; ++q) ccur[q] = cnx[q]; }
        } else if (pn == 5) {
#pragma unroll
            for (int ai = 0; ai < 2; ++ai)
#pragma unroll
                for (int m = 0; m < 4; ++m) { const int row = row0 + ai * HALF + m * 16; const float s = pr[ai * 4 + m];
#pragma unroll
                    for (int bj = 0; bj < 2; ++bj) *(u32x4*)(Vb + (size_t)row * 256 + bj * HALF + wc * 32 + 8 * fq) = pack8(acc[ai][bj][m][0] * s, acc[ai][bj][m][1] * s); }
        } else if (pn < 10) {
            const int colt = (pn - 6) * 256 + wc * 32 + 8 * fq;
#pragma unroll
            for (int ai = 0; ai < 2; ++ai)
#pragma unroll
                for (int m = 0; m < 4; ++m) { const int row = row0 + ai * HALF + m * 16; const float s = pr[ai * 4 + m];
#pragma unroll
                    for (int bj = 0; bj < 2; ++bj) { f32x4 y0 = acc[ai][bj][m][0] * s, y1 = acc[ai][bj][m][1] * s;
#pragma unroll
                        for (int j = 0; j < 4; ++j) { y0[j] = gelu_t(y0[j]); y1[j] = gelu_t(y1[j]); }
                        *(u32x4*)(GU + (size_t)row * 1024 + colt + bj * HALF) = pack8(y0, y1); } }
        } else {
            const int colt = (pn - 10) * 256 + wc * 32 + 8 * fq;
            f32x4 gg[2][2];
#pragma unroll
            for (int bj = 0; bj < 2; ++bj)
#pragma unroll
                for (int n = 0; n < 2; ++n) gg[bj][n] = *(const f32x4*)(gvn + colt + bj * HALF + 4 * n);
#pragma unroll
            for (int ai = 0; ai < 2; ++ai)
#pragma unroll
                for (int m = 0; m < 4; ++m) { const int row = row0 + ai * HALF + m * 16; const float s = pr[ai * 4 + m];
#pragma unroll
                    for (int bj = 0; bj < 2; ++bj) { f32x4 y0 = acc[ai][bj][m][0] * s, y1 = acc[ai][bj][m][1] * s;
#pragma unroll
                        for (int j = 0; j < 4; ++j) { y0[j] = gelu_t(y0[j]); y1[j] = gelu_t(y1[j]); }
                        float ss = dot4(y0) + dot4(y1); ss += __shfl_xor(ss, 16); ss += __shfl_xor(ss, 32);
                        if (fq == 0) partG[((size_t)row * 8 + (pn - 10) * 2 + bj) * 4 + wc] = ss;
                        *(u32x4*)(GV + (size_t)row * 1024 + colt + bj * HALF) = pack8(y0 * gg[bj][0], y1 * gg[bj][1]); } }
        }
    }
};

template <class Epi, class Sched, bool ALIGN_EPI = false, bool SP2 = false, int MIDK = 0, int MODE = 0>
__device__ __forceinline__ void gemm_phase(PG8_LAS unsigned char* lds, const Gemm g, const Sched& S, const Epi& E) {
    constexpr bool F8 = (MODE == 1), I8 = (MODE == 2);
    const int tid = threadIdx.x, wid = __builtin_amdgcn_readfirstlane(tid >> 6), lane = tid & 63, wr = wid >> 2, wc = wid & 3, fr = lane & 15, fq = lane >> 4;
    const int K = g.K, nt = K / BK;
    unsigned voffA[2], voffB[2];
#pragma unroll
    for (int i = 0; i < 2; ++i) { int R, C; stage_rc(tid * 16 + i * 8192, R, C); const int Rb = Epi::PERM ? ((R & ~31) + perm32(R & 31)) : R;
        voffA[i] = (unsigned)(R * K + C) * 2u; voffB[i] = (unsigned)(Rb * K + C) * 2u; }
    const size_t kstep = (size_t)(BK * 2);
    const size_t hstep = (size_t)HALF * K * 2;
    const size_t tstep = 2 * hstep;
    const unsigned ldsw = (unsigned)wid * 1024u;
    const int kc0 = F8 ? (32 * (fq >> 1) + 16 * (fq & 1)) : fq * 8;
    constexpr int KPIECE = F8 ? 16 : 1024;
    const int aoff = lds_byte(wr * 64 + fr, kc0), boff = lds_byte(wc * 32 + fr, kc0);
#define PG8_SA(b, h) (((b) * 2 + (h)) * HTB)
#define PG8_SB(b, h) ((4 + (b) * 2 + (h)) * HTB)
#define PG8_STAGE(bufoff, gbase, voff) do { _Pragma("unroll") for (int _i = 0; _i < 2; ++_i) \
        __builtin_amdgcn_global_load_lds((const unsigned*)((const char*)(gbase) + (voff)[_i]), (PG8_LAS unsigned*)(lds + (bufoff) + ldsw + _i * 8192), 16, 0, 0); } while (0)
#define PG8_LDA(dst, b, h) do { _Pragma("unroll") for (int m = 0; m < 4; ++m) { \
        if constexpr (F8) dst##8[m] = cat8(*(const PG8_LAS bf16x8*)(lds + PG8_SA(b, h) + aoff + m * 2048), *(const PG8_LAS bf16x8*)(lds + PG8_SA(b, h) + aoff + m * 2048 + KPIECE)); \
        else { _Pragma("unroll") for (int k = 0; k < 2; ++k) dst[m][k] = *(const PG8_LAS bf16x8*)(lds + PG8_SA(b, h) + aoff + m * 2048 + k * KPIECE); } } } while (0)
#define PG8_LDB(dst, b, h) do { _Pragma("unroll") for (int n = 0; n < 2; ++n) { \
        if constexpr (F8) dst##8[n] = cat8(*(const PG8_LAS bf16x8*)(lds + PG8_SB(b, h) + boff + n * 2048), *(const PG8_LAS bf16x8*)(lds + PG8_SB(b, h) + boff + n * 2048 + KPIECE)); \
        else { _Pragma("unroll") for (int k = 0; k < 2; ++k) dst[n][k] = *(const PG8_LAS bf16x8*)(lds + PG8_SB(b, h) + boff + n * 2048 + k * KPIECE); } } } while (0)
#define PG8_MMA(ai, bj, At, Bt) do { __builtin_amdgcn_s_setprio(1); _Pragma("unroll") for (int m = 0; m < 4; ++m) _Pragma("unroll") for (int n = 0; n < 2; ++n) { \
        if constexpr (F8) asm volatile("v_mfma_f32_16x16x128_f8f6f4 %0, %1, %2, %0" : "+v"(acc[ai][bj][m][n]) : "v"(Bt##8[n]), "v"(At##8[m]));   \
        else if constexpr (I8) { _Pragma("unroll") for (int k = 0; k < 2; ++k) acc[ai][bj][m][n] = __builtin_bit_cast(f32x4, __builtin_amdgcn_mfma_i32_16x16x64_i8(__builtin_bit_cast(i32x4, Bt[n][k]), __builtin_bit_cast(i32x4, At[m][k]), __builtin_bit_cast(i32x4, acc[ai][bj][m][n]), 0, 0, 0)); } \
        else { _Pragma("unroll") for (int k = 0; k < 2; ++k) acc[ai][bj][m][n] = __builtin_amdgcn_mfma_f32_16x16x32_bf16(Bt[n][k], At[m][k], acc[ai][bj][m][n], 0, 0, 0); } } __builtin_amdgcn_s_setprio(0); } while (0)
#define PG8_WAIT_V(n) asm volatile("s_waitcnt vmcnt(" #n ")" ::: "memory")
#define PG8_WAIT_L(n) asm volatile("s_waitcnt lgkmcnt(" #n ")" ::: "memory")
#define PG8_BAR __builtin_amdgcn_s_barrier()
#define PG8_SCHED __builtin_amdgcn_sched_barrier(0)
    Unit cur, nxt; int ui = 0;
    if (!S.next(0, cur)) return;
    f32x4 acc[2][2][4][2];
#pragma unroll
    for (int a = 0; a < 2; ++a)
#pragma unroll
        for (int b = 0; b < 2; ++b)
#pragma unroll
            for (int m = 0; m < 4; ++m)
#pragma unroll
                for (int n = 0; n < 2; ++n) acc[a][b][m][n] = (f32x4){0.f, 0.f, 0.f, 0.f};
    bf16x8 At[4][2], B0[2][2], B1[2][2]; i32x8 At8[4], B08[2], B18[2];
    float pre[8];
#pragma unroll
    for (int i = 0; i < 8; ++i) pre[i] = 0.f;
    const char* cA = (const char*)g.A + (size_t)cur.pm * tstep; const char* cB = (const char*)g.Bt + (size_t)cur.pn * tstep;
    S.a_ready(cur);
    if constexpr (SP2) {
        PG8_STAGE(PG8_SB(0, 0), cB, voffB); PG8_STAGE(PG8_SB(0, 1), cB + hstep, voffB); PG8_STAGE(PG8_SA(0, 0), cA, voffA); PG8_STAGE(PG8_SA(0, 1), cA + hstep, voffA);
        if (wr == 1) PG8_BAR;
        PG8_WAIT_V(2); PG8_BAR;
        PG8_STAGE(PG8_SB(1, 0), cB + kstep, voffB); PG8_STAGE(PG8_SA(1, 0), cA + kstep, voffA); PG8_STAGE(PG8_SB(1, 1), cB + hstep + kstep, voffB);
        PG8_WAIT_V(6); PG8_BAR;
    } else {
        PG8_STAGE(PG8_SB(0, 0), cB, voffB); PG8_STAGE(PG8_SA(0, 0), cA, voffA); PG8_STAGE(PG8_SB(0, 1), cB + hstep, voffB); PG8_STAGE(PG8_SA(0, 1), cA + hstep, voffA);
        if (wr == 1) PG8_BAR;
        PG8_WAIT_V(4); PG8_BAR;
        PG8_STAGE(PG8_SB(1, 0), cB + kstep, voffB); PG8_STAGE(PG8_SA(1, 0), cA + kstep, voffA); PG8_STAGE(PG8_SB(1, 1), cB + hstep + kstep, voffB);
        PG8_WAIT_V(6); PG8_BAR;
    }
    for (;;) {
        const bool has_next = S.next(ui + 1, nxt);
        const char* nA = has_next ? (const char*)g.A + (size_t)nxt.pm * tstep : cA; const char* nB = has_next ? (const char*)g.Bt + (size_t)nxt.pn * tstep : cB;
        for (int t = 0; t < nt; t += 2) {
            const bool last = (t == nt - 2);
            const char* a1 = cA + (size_t)(t + 1) * kstep;
            const char* a2 = last ? nA : cA + (size_t)(t + 2) * kstep; const char* b2 = last ? nB : cB + (size_t)(t + 2) * kstep;
            const char* a3 = a2 + kstep; const char* b3 = b2 + kstep;
            if (last && has_next) S.a_ready(nxt);
            if (last) E.pre(pre, cur, wr, fr);
            if constexpr (MIDK > 0) { if (t == MIDK / BK) E.mid(acc, cur, wr, wc, fr, fq); }
            if constexpr (SP2) {
            PG8_LDB(B0, 0, 0); PG8_LDB(B1, 0, 1); PG8_SCHED; PG8_LDA(At, 0, 0); PG8_STAGE(PG8_SA(1, 1), a1 + hstep, voffA);
            PG8_WAIT_V(8); PG8_WAIT_L(0); PG8_BAR; PG8_MMA(0, 0, At, B0); PG8_MMA(0, 1, At, B1); PG8_BAR; PG8_SCHED;
            PG8_LDA(At, 0, 1); PG8_STAGE(PG8_SB(0, 0), b2, voffB); PG8_STAGE(PG8_SB(0, 1), b2 + hstep, voffB); PG8_STAGE(PG8_SA(0, 0), a2, voffA);
            PG8_WAIT_V(8); PG8_WAIT_L(0); PG8_BAR; PG8_MMA(1, 0, At, B0); PG8_MMA(1, 1, At, B1); PG8_BAR; PG8_SCHED;
            PG8_LDB(B0, 1, 0); PG8_LDB(B1, 1, 1); PG8_SCHED; PG8_LDA(At, 1, 0); PG8_STAGE(PG8_SA(0, 1), a2 + hstep, voffA);
            PG8_WAIT_V(8); PG8_WAIT_L(0); PG8_BAR; PG8_MMA(0, 0, At, B0); PG8_MMA(0, 1, At, B1); PG8_BAR; PG8_SCHED;
            PG8_LDA(At, 1, 1); PG8_STAGE(PG8_SB(1, 0), b3, voffB); PG8_STAGE(PG8_SB(1, 1), b3 + hstep, voffB); PG8_STAGE(PG8_SA(1, 0), a3, voffA);
            PG8_WAIT_V(8); PG8_WAIT_L(0); PG8_BAR; PG8_MMA(1, 0, At, B0); PG8_MMA(1, 1, At, B1); PG8_BAR; PG8_SCHED;
            } else {
            PG8_LDB(B0, 0, 0); PG8_SCHED; PG8_LDA(At, 0, 0); PG8_STAGE(PG8_SA(1, 1), a1 + hstep, voffA);
            PG8_WAIT_L(8); PG8_BAR; PG8_WAIT_L(0); PG8_MMA(0, 0, At, B0); PG8_BAR; PG8_SCHED;
            PG8_LDB(B1, 0, 1); PG8_STAGE(PG8_SB(0, 0), b2, voffB);
            PG8_BAR; PG8_WAIT_L(0); PG8_MMA(0, 1, At, B1); PG8_BAR;
            PG8_LDA(At, 0, 1); PG8_STAGE(PG8_SA(0, 0), a2, voffA);
            PG8_BAR; PG8_WAIT_L(0); PG8_MMA(1, 0, At, B0); PG8_BAR; PG8_SCHED;
            PG8_STAGE(PG8_SB(0, 1), b2 + hstep, voffB);
            PG8_WAIT_V(6); PG8_BAR; PG8_MMA(1, 1, At, B1); PG8_BAR;
            PG8_LDB(B0, 1, 0); PG8_SCHED; PG8_LDA(At, 1, 0); PG8_STAGE(PG8_SA(0, 1), a2 + hstep, voffA);
            PG8_WAIT_L(8); PG8_BAR; PG8_WAIT_L(0); PG8_MMA(0, 0, At, B0); PG8_BAR; PG8_SCHED;
            PG8_LDB(B1, 1, 1); PG8_STAGE(PG8_SB(1, 0), b3, voffB);
            PG8_BAR; PG8_WAIT_L(0); PG8_MMA(0, 1, At, B1); PG8_BAR;
            PG8_LDA(At, 1, 1); PG8_STAGE(PG8_SA(1, 0), a3, voffA);
            PG8_BAR; PG8_WAIT_L(0); PG8_MMA(1, 0, At, B0); PG8_BAR; PG8_SCHED;
            PG8_STAGE(PG8_SB(1, 1), b3 + hstep, voffB);
            PG8_WAIT_V(6); PG8_BAR; PG8_MMA(1, 1, At, B1); PG8_BAR;
            }
        }
        if constexpr (F8) asm volatile("s_nop 15\n\ts_nop 15" ::: "memory");
        if constexpr (ALIGN_EPI) { if (wr == 0) PG8_BAR; }
        if constexpr (!Epi::AFTER_DRAIN) { E(acc, cur, wr, wc, fr, fq, pre); S.done(cur); }
        if (!has_next) break;
#pragma unroll
        for (int a = 0; a < 2; ++a)
#pragma unroll
            for (int b = 0; b < 2; ++b)
#pragma unroll
                for (int m = 0; m < 4; ++m)
#pragma unroll
                    for (int n = 0; n < 2; ++n) acc[a][b][m][n] = (f32x4){0.f, 0.f, 0.f, 0.f};
        cur = nxt; cA = nA; cB = nB; ++ui;
        if constexpr (ALIGN_EPI) { if (wr == 1) PG8_BAR; }
    }
    PG8_WAIT_V(0);
    if constexpr (!ALIGN_EPI) { if (wr == 0) PG8_BAR; }
    PG8_BAR;
    if constexpr (Epi::AFTER_DRAIN) { E.fused(acc, cur, wr, wc, fr, fq, lds, wid, lane); S.done(cur); }
#undef PG8_SA
#undef PG8_SB
#undef PG8_STAGE
#undef PG8_LDA
#undef PG8_LDB
#undef PG8_MMA
#undef PG8_WAIT_V
#undef PG8_WAIT_L
#undef PG8_BAR
#undef PG8_SCHED
}
}

constexpr int NWAVES = 8, NTHREADS = 512;
constexpr int BATCH = 2, SEQ = 16384, D = 2048, FF = 5632, NGU = 2 * FF, NIN = 3584;
constexpr int M = BATCH * SEQ;
constexpr float EPS = 1e-6f;
constexpr size_t MiB = 1u << 20;
constexpr size_t WS_WGU1 = 0, WS_WD1 = 44 * MiB, WS_WIN = 66 * MiB, WS_WOUT = 80 * MiB, WS_WGU2 = 88 * MiB, WS_WD2 = 132 * MiB;
constexpr size_t WS_WSB = 154 * MiB;
constexpr size_t WS_CS = 155 * MiB;
constexpr size_t WS_RS = 157 * MiB;
constexpr size_t WS_BAR = 157 * MiB + 768 * 1024;
constexpr size_t WS_PART = 158 * MiB;
constexpr size_t WS_PARTA = 162 * MiB;
constexpr size_t WS_PARTB = 164 * MiB;
constexpr size_t WS_PARTG = 165 * MiB;
constexpr size_t WS_XB = 170 * MiB;
constexpr size_t WS_H = 298 * MiB;
constexpr size_t WS_Q = WS_H, WS_K = WS_H + 64 * MiB, WS_V = WS_H + 80 * MiB, WS_GU = WS_H + 96 * MiB, WS_GV = WS_H + 160 * MiB, WS_AO = WS_H + 224 * MiB;
constexpr size_t WS_WGU2Q = WS_H + 352 * MiB;
constexpr size_t WS_AQ = WS_WGU2Q + 24 * MiB;
constexpr size_t WS_CMAX1 = WS_BAR + 16384, WS_CMAX2 = WS_CMAX1 + 45056;
constexpr size_t CTL_ZERO_BYTES = 16384 + 2 * 45056;
constexpr size_t WS_PMAX = WS_AQ + 64 * MiB;
constexpr size_t WS_WGU1Q = WS_PMAX + 4 * MiB;
constexpr size_t WS_END = WS_WGU1Q + 24 * MiB;
static_assert((size_t)M * FF * 2 == 352 * MiB && (size_t)M * D * 2 == 128 * MiB, "ws map");
constexpr int LDS_BYTES = 147456;

#define LAS __attribute__((address_space(3)))
typedef unsigned short bf16_t;
typedef short bf16x8 __attribute__((ext_vector_type(8)));
typedef float f32x4 __attribute__((ext_vector_type(4)));
typedef unsigned u32x4 __attribute__((ext_vector_type(4)));
typedef unsigned u32x2 __attribute__((ext_vector_type(2)));
using pg8::cvt_pk_bf16;
__device__ __forceinline__ float bf2f(unsigned b) { return __uint_as_float(b << 16); }
__device__ __forceinline__ float wave_sum(float v) {
#pragma unroll
    for (int o = 1; o < 64; o <<= 1) v += __shfl_xor(v, o);
    return v;
}

__device__ __forceinline__ int dest_row(int mode, int n) {
    if (mode == 0) return n;
    if (mode == 1) return ((n >> 7) << 8) + (n & 127);
    if (mode == 2) return ((n >> 7) << 8) + 128 + (n & 127);
    const int tile = n >> 8; if (tile > 4) return n;
    const int l = n & 255, wc = l >> 6, d = l & 63, fq = d >> 4, nn = (d >> 3) & 1, bj = (d >> 2) & 1, j = d & 3;
    return (tile << 8) + 128 * bj + 32 * wc + 8 * fq + 4 * nn + j;
}
template <bool HASG, bool F8OUT = false, bool TRACKMAX = false> __device__ __forceinline__ void transpose_item(const float* W, int K, int N, const float* g0, const float* g1, int gsplit, bf16_t* WT, int mode, LAS float* scr, int item, int lane, unsigned* wmaxp = nullptr) {
    const int nblk = N / 32, kb = item / nblk, nb = item % nblk, k0 = 64 * kb, n0 = 32 * nb; float mx = 0.f;
#pragma unroll 8
    for (int i = 0; i < 32; ++i) { const int kk = 2 * i + (lane >> 5), k = k0 + kk; float gk = 1.0f; if constexpr (HASG) gk = (k < gsplit) ? g0[k] : g1[k - gsplit];
        const float wv = W[(size_t)k * N + n0 + (lane & 31)] * gk; scr[kk * 33 + (lane & 31)] = wv; if constexpr (TRACKMAX) mx = fmaxf(mx, fabsf(wv)); }
    if constexpr (TRACKMAX) {
        mx = fmaxf(mx, __shfl_xor(mx, 32));
        if (lane < 32) __hip_atomic_fetch_max(wmaxp + dest_row(mode, n0 + lane), __float_as_uint(mx), __ATOMIC_RELAXED, __HIP_MEMORY_SCOPE_AGENT); }
    asm volatile("s_waitcnt lgkmcnt(0)" ::: "memory");
    const int c = lane & 7;
#pragma unroll
    for (int j = 0; j < 4; ++j) { const int n = (lane >> 3) + 8 * j; const LAS float* s = scr + (8 * c) * 33 + n;
        u32x4 o; o.x = cvt_pk_bf16(s[0 * 33], s[1 * 33]); o.y = cvt_pk_bf16(s[2 * 33], s[3 * 33]); o.z = cvt_pk_bf16(s[4 * 33], s[5 * 33]); o.w = cvt_pk_bf16(s[6 * 33], s[7 * 33]);
        if constexpr (F8OUT) { const f32x4 lo = (f32x4){s[0 * 33], s[1 * 33], s[2 * 33], s[3 * 33]} * 64.0f, hi = (f32x4){s[4 * 33], s[5 * 33], s[6 * 33], s[7 * 33]} * 64.0f;
            u32x2 o8; o8.x = pg8::pack4_fp8(lo); o8.y = pg8::pack4_fp8(hi); *(u32x2*)((unsigned char*)WT + (size_t)dest_row(mode, n0 + n) * K + k0 + 8 * c) = o8; }
        else *(u32x4*)(WT + (size_t)dest_row(mode, n0 + n) * K + k0 + 8 * c) = o; }
    asm volatile("s_waitcnt lgkmcnt(0)" ::: "memory");
}

struct Args { const void* in[21]; float* out; unsigned char* ws; int ph_lo, ph_hi; };

__device__ __forceinline__ void p0_prologue(const Args& A, LAS unsigned char* lds, int tid) {
    const int lane = tid & 63, wave = tid >> 6;
    LAS float* scr = (LAS float*)(lds + wave * 16384);
    const int gw = blockIdx.x * NWAVES + wave, NGW = gridDim.x * NWAVES;
    unsigned char* ws = A.ws;
    constexpr int I_G = (D / 64) * (FF / 32), I_DN = (FF / 64) * (D / 32), I_IN = (D / 64) * (NIN / 32), I_O = (D / 64) * (D / 32);
    constexpr int NITEMS = 4 * I_G + 2 * I_DN + I_IN + I_O;
    for (int it = gw; it < NITEMS; it += NGW) {
        int r = it;
        if (r < I_G) { transpose_item<true, false, true>((const float*)A.in[3], D, FF, (const float*)A.in[2], (const float*)A.in[2], 1 << 30, (bf16_t*)(ws + WS_WGU1), 1, scr, r, lane, (unsigned*)(ws + WS_CMAX1)); continue; } r -= I_G;
        if (r < I_G) { transpose_item<true, false, true>((const float*)A.in[4], D, FF, (const float*)A.in[2], (const float*)A.in[2], 1 << 30, (bf16_t*)(ws + WS_WGU1), 2, scr, r, lane, (unsigned*)(ws + WS_CMAX1)); continue; } r -= I_G;
        if (r < I_DN) { transpose_item<false>((const float*)A.in[5], FF, D, nullptr, nullptr, 0, (bf16_t*)(ws + WS_WD1), 0, scr, r, lane); continue; } r -= I_DN;
        if (r < I_IN) { transpose_item<true>((const float*)A.in[7], D, NIN, (const float*)A.in[6], (const float*)A.in[6], 1 << 30, (bf16_t*)(ws + WS_WIN), 3, scr, r, lane); continue; } r -= I_IN;
        if (r < I_O) { transpose_item<true>((const float*)A.in[16], D, D, (const float*)A.in[14], (const float*)A.in[15], 1024, (bf16_t*)(ws + WS_WOUT), 0, scr, r, lane); continue; } r -= I_O;
        if (r < I_G) { transpose_item<true, false, true>((const float*)A.in[18], D, FF, (const float*)A.in[17], (const float*)A.in[17], 1 << 30, (bf16_t*)(ws + WS_WGU2), 1, scr, r, lane, (unsigned*)(ws + WS_CMAX2)); continue; } r -= I_G;
        if (r < I_G) { transpose_item<true, false, true>((const float*)A.in[19], D, FF, (const float*)A.in[17], (const float*)A.in[17], 1 << 30, (bf16_t*)(ws + WS_WGU2), 2, scr, r, lane, (unsigned*)(ws + WS_CMAX2)); continue; } r -= I_G;
        transpose_item<false, true>((const float*)A.in[20], FF, D, nullptr, nullptr, 0, (bf16_t*)(ws + WS_WD2), 0, scr, r, lane);
    }
    const float* x = (const float*)A.in[0]; bf16_t* XB = (bf16_t*)(ws + WS_XB); float* rs1 = (float*)(ws + WS_RS);
    f32x4 vnx[8];
    if (gw < M) {
#pragma unroll
        for (int j = 0; j < 8; ++j) vnx[j] = ((const f32x4*)(x + (size_t)gw * D) + lane)[64 * j]; }
    for (int m = gw; m < M; m += NGW) {
        u32x2* o = (u32x2*)(XB + (size_t)m * D) + lane; unsigned* oq = (unsigned*)(ws + WS_AQ + (size_t)m * D) + lane; float s = 0.f, mx = 0.f;
        f32x4 v[8];
#pragma unroll
        for (int j = 0; j < 8; ++j) v[j] = vnx[j];
        if (m + NGW < M) {
#pragma unroll
            for (int j = 0; j < 8; ++j) vnx[j] = ((const f32x4*)(x + (size_t)(m + NGW) * D) + lane)[64 * j]; }
#pragma unroll
        for (int j = 0; j < 8; ++j) { s += pg8::dot4(v[j]); const f32x4 a = __builtin_elementwise_abs(v[j]); mx = fmaxf(mx, fmaxf(fmaxf(a[0], a[1]), fmaxf(a[2], a[3])));
            u32x2 w; w.x = cvt_pk_bf16(v[j][0], v[j][1]); w.y = cvt_pk_bf16(v[j][2], v[j][3]); o[64 * j] = w; }
        s = wave_sum(s);
#pragma unroll
        for (int of = 1; of < 64; of <<= 1) mx = fmaxf(mx, __shfl_xor(mx, of));
        mx = fmaxf(mx, 1e-30f); const float qs = 127.0f / mx;
#pragma unroll
        for (int j = 0; j < 8; ++j) { const f32x4 q = v[j] * qs;
            oq[64 * j] = ((unsigned)(int)__builtin_rintf(q[0]) & 0xffu) | (((unsigned)(int)__builtin_rintf(q[1]) & 0xffu) << 8) | (((unsigned)(int)__builtin_rintf(q[2]) & 0xffu) << 16) | (((unsigned)(int)__builtin_rintf(q[3]) & 0xffu) << 24); }
        if (lane == 0) rs1[m] = __builtin_amdgcn_rsqf(s * (1.0f / D) + EPS) * mx * (1.0f / 127.0f);
    }
    const int gt = blockIdx.x * NTHREADS + tid, NGT = gridDim.x * NTHREADS;
    const float* wsp = (const float*)A.in[12]; bf16_t* WSB = (bf16_t*)(ws + WS_WSB);
    for (int i = gt; i < 8 * 128 * 128 / 2; i += NGT) { const int e = 2 * i, s = e & 127, t = (e >> 7) & 127;
        const float a = (s <= t) ? wsp[e] : 0.f, b = (s + 1 <= t) ? wsp[e + 1] : 0.f; ((unsigned*)WSB)[i] = cvt_pk_bf16(a, b); }
    const int* pos = (const int*)A.in[1]; float* cs = (float*)(ws + WS_CS);
    for (int i = gt; i < M * 8; i += NGT) { const int m = i >> 3, f = i & 7;
        float invf = 1.0f;
        invf = f == 1 ? 0.19392274f : invf; invf = f == 2 ? 0.03760603f : invf; invf = f == 3 ? 0.0072926646f : invf; invf = f == 4 ? 0.0014142136f : invf;
        invf = f == 5 ? 0.0002742482f : invf; invf = f == 6 ? 5.3182957e-05f : invf; invf = f == 7 ? 1.0313385e-05f : invf;
        const float ang = (float)pos[m] * invf;
        const double rev = (double)ang * 0.15915494309189535; const float fr = (float)(rev - __builtin_rint(rev));
        cs[(size_t)m * 16 + f] = __builtin_amdgcn_cosf(fr); cs[(size_t)m * 16 + 8 + f] = __builtin_amdgcn_sinf(fr); }
}

__device__ __forceinline__ unsigned q8pair(unsigned w, float sc) {
    const int a = (int)__builtin_rintf(__builtin_amdgcn_fmed3f(bf2f(w & 0xffffu) * sc, -127.0f, 127.0f)), b = (int)__builtin_rintf(__builtin_amdgcn_fmed3f(bf2f(w >> 16) * sc, -127.0f, 127.0f));
    return ((unsigned)a & 0xffu) | (((unsigned)b & 0xffu) << 8);
}
__device__ __forceinline__ u32x2 q8x8(const u32x4 w, float sc) { u32x2 o; o.x = q8pair(w.x, sc) | (q8pair(w.y, sc) << 16); o.y = q8pair(w.z, sc) | (q8pair(w.w, sc) << 16); return o; }
__device__ __forceinline__ void quantize_wgu(const unsigned char* srcb, unsigned char* dstb, const unsigned* cmax, int tid) {
    const u32x4* src = (const u32x4*)srcb; u32x2* dst = (u32x2*)dstb;
    constexpr int NU = 8, TOTAL = NGU * D / 8;
    const int stride = gridDim.x * NTHREADS;
    for (int i0 = blockIdx.x * NTHREADS + tid; i0 < TOTAL; i0 += NU * stride) {
        u32x4 v[NU]; unsigned cm[NU];
#pragma unroll
        for (int u = 0; u < NU; ++u) { const int i = i0 + u * stride; const int ii = i < TOTAL ? i : i0; v[u] = src[ii]; cm[u] = __hip_atomic_load(cmax + (ii >> 8), __ATOMIC_RELAXED, __HIP_MEMORY_SCOPE_AGENT); }
#pragma unroll
        for (int u = 0; u < NU; ++u) { const int i = i0 + u * stride; if (i < TOTAL) dst[i] = q8x8(v[u], 127.0f / fmaxf(__uint_as_float(cm[u]), 1e-30f)); }
    }
}
__device__ __forceinline__ void quantize_x2(unsigned char* ws, const float* part, float* rowfac, int tid) {
    const int lane = tid & 63, gw = blockIdx.x * NWAVES + (tid >> 6), NGW = gridDim.x * NWAVES;
    const bf16_t* XB = (const bf16_t*)(ws + WS_XB); unsigned char* AQ = ws + WS_AQ; const float* pmax = (const float*)(ws + WS_PMAX);
    constexpr int NR = 4;
    for (int m0 = gw; m0 < M; m0 += NR * NGW) {
        float p[NR], mx[NR]; u32x4 v[NR][4];
#pragma unroll
        for (int r = 0; r < NR; ++r) { const int m = m0 + r * NGW; const bool ok = m < M; const size_t mm = ok ? (size_t)m : 0;
            p[r] = (lane < 32) ? part[mm * 32 + lane] : 0.f; mx[r] = (lane < 32) ? pmax[mm * 32 + lane] : 0.f;
            const u32x4* src = (const u32x4*)(XB + mm * D) + lane;
#pragma unroll
            for (int j = 0; j < 4; ++j) v[r][j] = src[64 * j]; }
#pragma unroll
        for (int r = 0; r < NR; ++r) { const int m = m0 + r * NGW; if (m >= M) break;
            const float ps = wave_sum(p[r]); float mxr = mx[r];
#pragma unroll
            for (int of = 1; of < 64; of <<= 1) mxr = fmaxf(mxr, __shfl_xor(mxr, of));
            mxr = fmaxf(mxr, 1e-30f); const float sc = 127.0f / mxr;
            u32x2* dst = (u32x2*)(AQ + (size_t)m * D) + lane;
#pragma unroll
            for (int j = 0; j < 4; ++j) dst[64 * j] = q8x8(v[r][j], sc);
            if (lane == 0) rowfac[m] = __builtin_amdgcn_rsqf(ps * (1.0f / D) + EPS) * mxr * (1.0f / 127.0f); }
    }
}
template <int NP> __device__ __forceinline__ void rs_finalize(const float* part, float* rs, float inv_width, int tid) {
    for (int m = blockIdx.x * NTHREADS + tid; m < M; m += gridDim.x * NTHREADS) { const f32x4* p = (const f32x4*)(part + (size_t)m * NP); float s = 0.f;
#pragma unroll
        for (int j = 0; j < NP / 4; ++j) { const f32x4 v = p[j]; s += (v[0] + v[1]) + (v[2] + v[3]); }
        rs[m] = __builtin_amdgcn_rsqf(s * inv_width + EPS); }
}

constexpr int KS_STRIDE = 144, VT_OFF = 256 * KS_STRIDE, VT_STRIDE = 528, ATT_BUF = VT_OFF + 64 * VT_STRIDE;
static_assert(2 * ATT_BUF <= LDS_BYTES, "two attention staging buffers");
struct AttnKV { u32x4 k[4], va[2], vb[2]; };
__device__ __forceinline__ void attn_load(AttnKV& R, bf16x8 (&q)[8], int au, const bf16_t* Qg, const bf16_t* Kg, const bf16_t* Vg, int tid) {
    const int wid = tid >> 6, lane = tid & 63, fr = lane & 15, fq = lane >> 4;
    const int b = au >> 9, blk = (au >> 2) & 127, kvh = au & 3;
    const int tok0 = b * SEQ + blk * 128;
#pragma unroll
    for (int it = 0; it < 4; ++it) { const int c = it * NTHREADS + tid, key = c >> 3, dc = c & 7;
        u32x4 v = (u32x4){0u, 0u, 0u, 0u};
        if (blk > 0 || key >= 128) v = *(const u32x4*)(Kg + (size_t)(tok0 - 128 + key) * 256 + kvh * 64 + dc * 8);
        R.k[it] = v; }
#pragma unroll
    for (int it = 0; it < 2; ++it) { const int task = it * NTHREADS + tid, p = task & 127, dc = task >> 7, key0 = 2 * p;
        u32x4 a = (u32x4){0u, 0u, 0u, 0u}, bb = a;
        if (blk > 0 || key0 >= 128) { const bf16_t* src = Vg + (size_t)(tok0 - 128 + key0) * 256 + kvh * 64 + dc * 8; a = *(const u32x4*)src; bb = *(const u32x4*)(src + 256); }
        R.va[it] = a; R.vb[it] = bb; }
    const int hq = kvh * 4 + (wid >> 1), i0 = (wid & 1) * 64;
#pragma unroll
    for (int s = 0; s < 4; ++s) { const bf16_t* qp = Qg + (size_t)(tok0 + i0 + 16 * s + fr) * 1024 + hq * 64 + fq * 8; q[2 * s] = *(const bf16x8*)qp; q[2 * s + 1] = *(const bf16x8*)(qp + 32); }
}
__device__ __forceinline__ void attn_store_lds(const AttnKV& R, LAS unsigned char* lds, int tid) {
#pragma unroll
    for (int it = 0; it < 4; ++it) { const int c = it * NTHREADS + tid, key = c >> 3, dc = c & 7; *(LAS u32x4*)(lds + key * KS_STRIDE + dc * 16) = R.k[it]; }
#pragma unroll
    for (int it = 0; it < 2; ++it) { const int task = it * NTHREADS + tid, p = task & 127, dc = task >> 7;
#pragma unroll
        for (int i = 0; i < 4; ++i) { const unsigned wa = R.va[it][i], wb = R.vb[it][i];
            *(LAS unsigned*)(lds + VT_OFF + (dc * 8 + 2 * i) * VT_STRIDE + p * 4) = (wa & 0xffffu) | (wb << 16);
            *(LAS unsigned*)(lds + VT_OFF + (dc * 8 + 2 * i + 1) * VT_STRIDE + p * 4) = (wa >> 16) | (wb & 0xffff0000u); } }
}
__device__ __forceinline__ void attn_compute(LAS unsigned char* lds, int au, const bf16x8 (&q)[8], bf16_t* AO, float* partA, const float sink, int tid) {
    const int wid = __builtin_amdgcn_readfirstlane(tid >> 6), lane = tid & 63, fr = lane & 15, fq = lane >> 4;
    const int b = au >> 9, blk = (au >> 2) & 127, kvh = au & 3;
    const int tok0 = b * SEQ + blk * 128;
    const int g = wid >> 1, i0 = (wid & 1) * 64, hq = kvh * 4 + g;
#pragma unroll
    for (int s = 0; s < 4; ++s) {
        const int qi = i0 + 16 * s + fr;
        const bf16x8 q0 = q[2 * s], q1 = q[2 * s + 1];
        const int T0e = ((i0 >> 4) + s) & ~1;
        f32x4 sc[10];
#pragma unroll
        for (int tt = 0; tt < 10; ++tt) { const int rel = 16 * tt - 16 * (s & 1);
            if (rel < 0 || rel > 128) { sc[tt] = (f32x4){0.f, 0.f, 0.f, 0.f}; continue; }
            const LAS unsigned char* kp = lds + (16 * (T0e + tt) + fr) * KS_STRIDE + fq * 16;
            const bf16x8 k0 = *(const LAS bf16x8*)kp, k1 = *(const LAS bf16x8*)(kp + 64);
            f32x4 a = (f32x4){0.f, 0.f, 0.f, 0.f};
            a = __builtin_amdgcn_mfma_f32_16x16x32_bf16(k0, q0, a, 0, 0, 0); a = __builtin_amdgcn_mfma_f32_16x16x32_bf16(k1, q1, a, 0, 0, 0); sc[tt] = a; }
        float mx = -1e30f;
#pragma unroll
        for (int tt = 0; tt < 10; ++tt) { const int rel = 16 * tt - 16 * (s & 1);
            if (rel < 0 || rel > 128) continue;
            if (rel >= 16 && rel <= 112) { const bool tv = (blk > 0) || (T0e + tt >= 8);
#pragma unroll
                for (int j = 0; j < 4; ++j) { const float v = tv ? sc[tt][j] : -1e30f; sc[tt][j] = v; mx = fmaxf(mx, v); } }
            else {
#pragma unroll
                for (int j = 0; j < 4; ++j) { const int kj = 16 * (T0e + tt) + 4 * fq + j, diff = qi + 128 - kj;
                    const bool valid = (diff >= 0) && (diff < 128) && (blk > 0 || kj >= 128);
                    const float v = valid ? sc[tt][j] : -1e30f; sc[tt][j] = v; mx = fmaxf(mx, v); } } }
        mx = fmaxf(mx, __shfl_xor(mx, 16)); mx = fmaxf(mx, __shfl_xor(mx, 32)); mx = fmaxf(mx, sink);
        float l = 0.f;
#pragma unroll
        for (int tt = 0; tt < 10; ++tt) { const int rel = 16 * tt - 16 * (s & 1);
            if (rel < 0 || rel > 128) continue;
#pragma unroll
            for (int j = 0; j < 4; ++j) { const float p = __builtin_amdgcn_exp2f(sc[tt][j] - mx); sc[tt][j] = p; l += p; } }
        l += __shfl_xor(l, 16); l += __shfl_xor(l, 32); l += __builtin_amdgcn_exp2f(sink - mx);
        f32x4 o[4];
#pragma unroll
        for (int dt = 0; dt < 4; ++dt) o[dt] = (f32x4){0.f, 0.f, 0.f, 0.f};
#pragma unroll
        for (int u = 0; u < 5; ++u) { const u32x4 pw = pg8::pack8(sc[2 * u], sc[2 * u + 1]); const bf16x8 pf = __builtin_bit_cast(bf16x8, pw);
#pragma unroll
            for (int dt = 0; dt < 4; ++dt) { const LAS unsigned char* vp = lds + VT_OFF + (16 * dt + fr) * VT_STRIDE + (16 * (T0e + 2 * u) + 4 * fq) * 2;
                const u32x2 lo = *(const LAS u32x2*)vp, hi = *(const LAS u32x2*)(vp + 32);
                const u32x4 vw = (u32x4){lo.x, lo.y, hi.x, hi.y};
                o[dt] = __builtin_amdgcn_mfma_f32_16x16x32_bf16(__builtin_bit_cast(bf16x8, vw), pf, o[dt], 0, 0, 0); } }
        const float inv = 1.0f / l; float ss = 0.f;
        bf16_t* op = AO + (size_t)(tok0 + qi) * 2048 + hq * 64 + 4 * fq;
#pragma unroll
        for (int dt = 0; dt < 4; ++dt) { const f32x4 v = o[dt] * inv; ss += pg8::dot4(v); u32x2 w; w.x = cvt_pk_bf16(v[0], v[1]); w.y = cvt_pk_bf16(v[2], v[3]); *(u32x2*)(op + 16 * dt) = w; }
        ss += __shfl_xor(ss, 16); ss += __shfl_xor(ss, 32);
        if (fq == 0) partA[(size_t)(tok0 + qi) * 16 + hq] = ss;
    }
}

constexpr int GT_STRIDE = 272, GM_BUF = 128 * GT_STRIDE;
struct GmlpIn { u32x4 a[2], b[2]; f32x4 pa[2], pb[2]; };
__device__ __forceinline__ void gmlp_load(GmlpIn& R, int gu, const bf16_t* GV, const float* partG, int tid) {
    const int b = gu >> 10, chunk = (gu >> 3) & 127, g = gu & 7;
    const int tok0 = b * SEQ + chunk * 128;
#pragma unroll
    for (int it = 0; it < 2; ++it) { const int task = it * NTHREADS + tid, p = task & 63, cc = task >> 6; const int row0 = tok0 + 2 * p;
        const bf16_t* src = GV + (size_t)row0 * 1024 + g * 128 + cc * 8;
        R.a[it] = *(const u32x4*)src; R.b[it] = *(const u32x4*)(src + 1024);
        R.pa[it] = *(const f32x4*)(partG + ((size_t)row0 * 8 + g) * 4); R.pb[it] = *(const f32x4*)(partG + ((size_t)(row0 + 1) * 8 + g) * 4); }
}
__device__ __forceinline__ void gmlp_store_lds(const GmlpIn& R, LAS unsigned char* lds, int tid) {
#pragma unroll
    for (int it = 0; it < 2; ++it) { const int task = it * NTHREADS + tid, p = task & 63, cc = task >> 6;
        const f32x4 pa = R.pa[it], pb = R.pb[it];
        const float rsa = __builtin_amdgcn_rsqf(((pa[0] + pa[1]) + (pa[2] + pa[3])) * (1.0f / 128.0f) + EPS), rsb = __builtin_amdgcn_rsqf(((pb[0] + pb[1]) + (pb[2] + pb[3])) * (1.0f / 128.0f) + EPS);
#pragma unroll
        for (int i = 0; i < 4; ++i) { const unsigned wa = R.a[it][i], wb = R.b[it][i];
            *(LAS unsigned*)(lds + (cc * 8 + 2 * i) * GT_STRIDE + p * 4) = cvt_pk_bf16(bf2f(wa & 0xffffu) * rsa, bf2f(wb & 0xffffu) * rsb);
            *(LAS unsigned*)(lds + (cc * 8 + 2 * i + 1) * GT_STRIDE + p * 4) = cvt_pk_bf16(bf2f(wa >> 16) * rsa, bf2f(wb >> 16) * rsb); } }
}
struct GmlpCur { u32x2 gw[8]; bf16x8 wf[4]; float bias; };
__device__ __forceinline__ void gmlp_cur_load(GmlpCur& C, int gu, const bf16_t* GU, const bf16_t* WSB, const float* bsp, int tid) {
    const int wid = tid >> 6, lane = tid & 63, fr = lane & 15, fq = lane >> 4;
    const int b = gu >> 10, chunk = (gu >> 3) & 127, g = gu & 7;
    const int t = 16 * wid + fr, row = b * SEQ + chunk * 128 + t;
#pragma unroll
    for (int ks = 0; ks < 4; ++ks) C.wf[ks] = *(const bf16x8*)(WSB + (size_t)(g * 128 + t) * 128 + 32 * ks + 8 * fq);
#pragma unroll
    for (int ct = 0; ct < 8; ++ct) C.gw[ct] = *(const u32x2*)(GU + (size_t)row * 1024 + g * 128 + 16 * ct + 4 * fq);
    C.bias = bsp[g * 128 + t];
}
__device__ __forceinline__ void gmlp_compute(LAS unsigned char* lds, int gu, const GmlpCur& C, bf16_t* AO, float* partB, int tid) {
    const int wid = __builtin_amdgcn_readfirstlane(tid >> 6), lane = tid & 63, fr = lane & 15, fq = lane >> 4;
    const int b = gu >> 10, chunk = (gu >> 3) & 127, g = gu & 7;
    const int tok0 = b * SEQ + chunk * 128;
    const int t = 16 * wid + fr, nks = (wid >> 1) + 1, row = tok0 + t;
    const float bias = C.bias;
    f32x4 acc[8];
#pragma unroll
    for (int ct = 0; ct < 8; ++ct) acc[ct] = (f32x4){0.f, 0.f, 0.f, 0.f};
#pragma unroll
    for (int ks = 0; ks < 4; ++ks) if (ks < nks) {
#pragma unroll
        for (int ct = 0; ct < 8; ++ct) { const bf16x8 af = *(const LAS bf16x8*)(lds + (16 * ct + fr) * GT_STRIDE + (32 * ks + 8 * fq) * 2);
            acc[ct] = __builtin_amdgcn_mfma_f32_16x16x32_bf16(af, C.wf[ks], acc[ct], 0, 0, 0); } }
    float ss = 0.f;
#pragma unroll
    for (int ct = 0; ct < 8; ++ct) { const int col = g * 128 + 16 * ct + 4 * fq; const u32x2 gw = C.gw[ct];
        f32x4 v; v[0] = bf2f(gw.x & 0xffffu) * (acc[ct][0] + bias); v[1] = bf2f(gw.x >> 16) * (acc[ct][1] + bias); v[2] = bf2f(gw.y & 0xffffu) * (acc[ct][2] + bias); v[3] = bf2f(gw.y >> 16) * (acc[ct][3] + bias);
        ss += pg8::dot4(v); u32x2 w; w.x = cvt_pk_bf16(v[0], v[1]); w.y = cvt_pk_bf16(v[2], v[3]);
        *(u32x2*)(AO + (size_t)row * 2048 + 1024 + col) = w; }
    ss += __shfl_xor(ss, 16); ss += __shfl_xor(ss, 32);
    if (fq == 0) partB[(size_t)row * 8 + g] = ss;
}

__device__ __forceinline__ void mixer_phase(LAS unsigned char* lds, unsigned char* ws, const float* sinks, const float* bsp, int tid) {
    const int G = gridDim.x;
    const bf16_t* Qg = (const bf16_t*)(ws + WS_Q); const bf16_t* Kg = (const bf16_t*)(ws + WS_K); const bf16_t* Vg = (const bf16_t*)(ws + WS_V);
    const bf16_t* GU = (const bf16_t*)(ws + WS_GU); const bf16_t* GV = (const bf16_t*)(ws + WS_GV); const bf16_t* WSB = (const bf16_t*)(ws + WS_WSB);
    bf16_t* AO = (bf16_t*)(ws + WS_AO); float* partA = (float*)(ws + WS_PARTA); float* partB = (float*)(ws + WS_PARTB); const float* partG = (const float*)(ws + WS_PARTG);
    {
        constexpr int NA = BATCH * 128 * 4;
        int au = blockIdx.x, par = 0; AttnKV R; bf16x8 q[8], qn[8];
        if (au < NA) { attn_load(R, q, au, Qg, Kg, Vg, tid); attn_store_lds(R, lds, tid); }
        __syncthreads();
        for (; au < NA; au += G) { const int an = au + G; const bool hn = an < NA;
#pragma unroll
            for (int i = 0; i < 8; ++i) qn[i] = q[i];
            const float sink = sinks[(au & 3) * 4 + (__builtin_amdgcn_readfirstlane(tid >> 6) >> 1)] * 1.4426950408889634f;
            asm volatile("" :: "v"(sink));
            if (hn) attn_load(R, qn, an, Qg, Kg, Vg, tid);
            attn_compute(lds + par * ATT_BUF, au, q, AO, partA, sink, tid);
            if (hn) attn_store_lds(R, lds + (par ^ 1) * ATT_BUF, tid);
            __syncthreads();
#pragma unroll
            for (int i = 0; i < 8; ++i) q[i] = qn[i];
            par ^= 1; }
    }
    {
        constexpr int NG = BATCH * 128 * 8;
        int gu = blockIdx.x, par = 0; GmlpIn R;
        if (gu < NG) { gmlp_load(R, gu, GV, partG, tid); gmlp_store_lds(R, lds, tid); }
        __syncthreads();
        for (; gu < NG; gu += G) { const int gn = gu + G; const bool hn = gn < NG;
            GmlpCur C; gmlp_cur_load(C, gu, GU, WSB, bsp, tid);
            if (hn) gmlp_load(R, gn, GV, partG, tid);
            gmlp_compute(lds + par * GM_BUF, gu, C, AO, partB, tid);
            if (hn) gmlp_store_lds(R, lds + (par ^ 1) * GM_BUF, tid);
            __syncthreads();
            par ^= 1; }
    }
}

#define XB_TMO      128
#define XB_XCNT(j)  (256  + 64 * (j))
#define XB_XSUB(j)  (1280 + 64 * (j))
#define XB_XGEN(j)  (2304 + 64 * (j))
#define XB_TOP      3328
#define XB_TOPGEN   3392
#define XCD_BAR_WORDS 3456
#define XB_SPIN_CAP (1u << 18)

__device__ __forceinline__ unsigned xb_ld(unsigned* p)              { return __hip_atomic_load(p, __ATOMIC_RELAXED, __HIP_MEMORY_SCOPE_AGENT); }
__device__ __forceinline__ unsigned xb_add(unsigned* p, unsigned v) { return __hip_atomic_fetch_add(p, v, __ATOMIC_RELAXED, __HIP_MEMORY_SCOPE_AGENT); }
__device__ __forceinline__ unsigned xb_xcc_id() { return (unsigned)__builtin_amdgcn_s_getreg((3 << 11) | 20) & 0xFu; }
#define XB_SPIN(cond, bar) do { unsigned _sp = 0; while (cond) { __builtin_amdgcn_s_sleep(1); \
    if ((++_sp & 255u) == 0u) { if (xb_ld(&(bar)[XB_TMO])) break; if (_sp > XB_SPIN_CAP) { atomicAdd(&(bar)[XB_TMO], 1u); break; } } } } while (0)

struct XcdBarrier {
    unsigned* bar; unsigned x;
    volatile LAS unsigned* st;
};

__device__ __forceinline__ XcdBarrier xcd_barrier_post(unsigned* bar, volatile LAS unsigned* st) {
    XcdBarrier b; b.bar = bar; b.x = xb_xcc_id(); b.st = st;
    if (threadIdx.x == 0) (void)xb_add(&bar[XB_XCNT(b.x)], 1u);
    return b;
}
__device__ __forceinline__ void xcd_barrier_complete(unsigned* bar, unsigned x, unsigned& nloc, unsigned& nx) {
    const unsigned G = gridDim.x * gridDim.y * gridDim.z;
    unsigned sum, cnt, mine, sp = 0u;
    for (;;) {
        sum = 0u; cnt = 0u; mine = 0u;
#pragma unroll
        for (unsigned j = 0; j < 16; ++j) { const unsigned c = xb_ld(&bar[XB_XCNT(j)]); sum += c; cnt += (c > 0u) ? 1u : 0u; mine = (j == x) ? c : mine; }
        if (sum == G) break;
        __builtin_amdgcn_s_sleep(1);
        if ((++sp & 255u) == 0u) { if (xb_ld(&bar[XB_TMO])) break; if (sp > XB_SPIN_CAP) { atomicAdd(&bar[XB_TMO], 1u); break; } }
    }
    nloc = mine > 0u ? mine : 1u; nx = cnt > 0u ? cnt : 1u;
}

__device__ __forceinline__ void xcd_barrier(const XcdBarrier& b) {
    asm volatile("s_waitcnt vmcnt(0)" ::: "memory");
    __syncthreads();
    if (threadIdx.x == 0) {
        unsigned* bar = b.bar;
        __builtin_amdgcn_s_waitcnt(0);
        unsigned nloc = b.st[0], nx = b.st[1];
        if (nloc == 0u) { xcd_barrier_complete(bar, b.x, nloc, nx); b.st[0] = nloc; b.st[1] = nx; }
        const unsigned old = xb_add(&bar[XB_XSUB(b.x)], 1u);
        const unsigned gen = old / nloc;
        if (old + 1u == (gen + 1u) * nloc) {
            __builtin_amdgcn_fence(__ATOMIC_RELEASE, "agent");
            asm volatile("s_waitcnt vmcnt(0)" ::: "memory");
            const unsigned og = xb_add(&bar[XB_TOP], 1u);
            const unsigned tg = og / nx;
            if (og + 1u == (tg + 1u) * nx) xb_add(&bar[XB_TOPGEN], 1u);
            else XB_SPIN(xb_ld(&bar[XB_TOPGEN]) == tg, bar);
            __builtin_amdgcn_fence(__ATOMIC_ACQUIRE, "agent");
            xb_add(&bar[XB_XGEN(b.x)], 1u);
            asm volatile("s_waitcnt vmcnt(0)" ::: "memory");
        } else {
            XB_SPIN(xb_ld(&bar[XB_XGEN(b.x)]) == gen, bar);
            __builtin_amdgcn_fence(__ATOMIC_ACQUIRE, "agent");
            asm volatile("s_waitcnt vmcnt(0)" ::: "memory");
        }
    }
    __syncthreads();
}

#ifndef MK_SPLIT
#define MK_SPLIT 0
#endif
#define NPHASE 11
#ifndef MK_PROBE_HI1
#define MK_PROBE_HI1 NPHASE
#define MK_PROBE_LO2 0
#endif
__global__ void __launch_bounds__(NTHREADS, 2) hymba_fwd(Args A) {
    extern __shared__ __attribute__((aligned(16))) unsigned char lds_raw[];
    LAS unsigned char* lds = (LAS unsigned char*)lds_raw;
    cg::grid_group grid = cg::this_grid();
    const int tid = threadIdx.x, G = gridDim.x, lo = A.ph_lo, hi = A.ph_hi;
    unsigned char* ws = A.ws;
    float* rsb = (float*)(ws + WS_RS); float *rs1 = rsb, *rs2 = rsb + M, *rsA = rsb + 2 * M, *rsB = rsb + 3 * M, *rs3 = rsb + 4 * M;
    bf16_t* XB = (bf16_t*)(ws + WS_XB); bf16_t* H = (bf16_t*)(ws + WS_H); bf16_t* AO = (bf16_t*)(ws + WS_AO);
    float* part = (float*)(ws + WS_PART); float* partA = (float*)(ws + WS_PARTA); float* partB = (float*)(ws + WS_PARTB); float* partG = (float*)(ws + WS_PARTG);
#define IN(k) (lo <= (k) && (k) < hi)
    volatile LAS unsigned* bst = (volatile LAS unsigned*)(lds + LDS_BYTES - 16);
    if (tid < 4) bst[tid] = 0u;
    __syncthreads();
    const XcdBarrier bar = xcd_barrier_post((unsigned*)(ws + WS_BAR), bst);
#define SEAM(k) do { if (IN(k) && IN((k) + 1)) xcd_barrier(bar); } while (0)
    if (lo < 0) grid.sync();
    if (IN(0)) { p0_prologue(A, lds, tid); __syncthreads(); xcd_barrier(bar);
        quantize_wgu(ws + WS_WGU1, ws + WS_WGU1Q, (const unsigned*)(ws + WS_CMAX1), tid); quantize_wgu(ws + WS_WGU2, ws + WS_WGU2Q, (const unsigned*)(ws + WS_CMAX2), tid); }
    SEAM(0);
    if (IN(1)) {
        pg8::Gemm g{(const bf16_t*)(ws + WS_AQ), (const bf16_t*)(ws + WS_WGU1Q), M, NGU, D / 2}; pg8::StaticOrder S; S.init(M, NGU, G, (int)blockIdx.x);
        pg8::EpiSwiglu<false, true> E{H, rs1, FF, 1.0f, (const unsigned*)(ws + WS_CMAX1)};
        pg8::gemm_phase<pg8::EpiSwiglu<false, true>, pg8::StaticOrder, true, true, 0, 2>(lds, g, S, E);
    }
    SEAM(1);
    if (IN(2)) {
        pg8::Gemm g{H, (const bf16_t*)(ws + WS_WD1), M, D, FF}; pg8::StaticOrder S; S.init(M, D, G, (int)blockIdx.x);
        pg8::EpiResid<false, true, false> E{A.out, XB, part, nullptr, nullptr, 0.5f, nullptr};
        pg8::gemm_phase<pg8::EpiResid<false, true, false>, pg8::StaticOrder, true, true>(lds, g, S, E);
    }
    SEAM(2);
#define MY_PANELS(S_, ...) do { int prev_ = -1; pg8::Unit u_; for (int i_ = 0; (S_).next(i_, u_); ++i_) if (u_.pm != prev_) { prev_ = u_.pm; if (tid < 256) { const int m = u_.pm * 256 + tid; __VA_ARGS__ } } asm volatile("s_waitcnt vmcnt(0)" ::: "memory"); __syncthreads(); } while (0)
    if (IN(4)) {
        pg8::Gemm g{XB, (const bf16_t*)(ws + WS_WIN), M, NIN, D}; pg8::StaticOrder S; S.init(M, NIN, G, (int)blockIdx.x);
        MY_PANELS(S, { const f32x4* p = (const f32x4*)(part + (size_t)m * 32); float sm = 0.f;
            for (int j = 0; j < 8; ++j) { const f32x4 v = p[j]; sm += (v[0] + v[1]) + (v[2] + v[3]); }
            rs2[m] = __builtin_amdgcn_rsqf(sm * (1.0f / D) + EPS); });
        pg8::EpiIn E{(bf16_t*)(ws + WS_Q), (bf16_t*)(ws + WS_K), (bf16_t*)(ws + WS_V), (bf16_t*)(ws + WS_GU), (bf16_t*)(ws + WS_GV), rs2,
                     (const float*)A.in[8], (const float*)A.in[9], (const float*)A.in[11], (const float*)(ws + WS_CS), partG};
        pg8::gemm_phase<pg8::EpiIn, pg8::StaticOrder, true, true>(lds, g, S, E);
    }
    SEAM(4);
    if (IN(5)) mixer_phase(lds, ws, (const float*)A.in[10], (const float*)A.in[13], tid);
    SEAM(5);
    if (IN(7)) {
        pg8::Gemm g{AO, (const bf16_t*)(ws + WS_WOUT), M, D, D}; pg8::StaticOrder S; S.init(M, D, G, (int)blockIdx.x);
        MY_PANELS(S, { const f32x4* pa = (const f32x4*)(partA + (size_t)m * 16); const f32x4* pb = (const f32x4*)(partB + (size_t)m * 8); float sa = 0.f, sb = 0.f;
            for (int j = 0; j < 4; ++j) { const f32x4 v = pa[j]; sa += (v[0] + v[1]) + (v[2] + v[3]); }
            for (int j = 0; j < 2; ++j) { const f32x4 v = pb[j]; sb += (v[0] + v[1]) + (v[2] + v[3]); }
            const float ra = __builtin_amdgcn_rsqf(sa * (1.0f / 1024.0f) + EPS), rb = __builtin_amdgcn_rsqf(sb * (1.0f / 1024.0f) + EPS);
            rsA[m] = ra / rb; rsB[m] = rb; });
        pg8::EpiResid<true, true, false> E{A.out, XB, part, rsA, rsB, 0.f, (float*)(ws + WS_PMAX)};
        pg8::gemm_phase<pg8::EpiResid<true, true, false>, pg8::StaticOrder, true, true, 1024>(lds, g, S, E);
    }
    SEAM(7);
    if (IN(8)) quantize_x2(ws, part, rs3, tid);
    SEAM(8);
    if (IN(9)) {
        pg8::Gemm g{(const bf16_t*)(ws + WS_AQ), (const bf16_t*)(ws + WS_WGU2Q), M, NGU, D / 2}; pg8::StaticOrder S; S.init(M, NGU, G, (int)blockIdx.x);
        pg8::EpiSwiglu<true, true> E{H, rs3, FF, 4.0f, (const unsigned*)(ws + WS_CMAX2)};
        pg8::gemm_phase<pg8::EpiSwiglu<true, true>, pg8::StaticOrder, true, true, 0, 2>(lds, g, S, E);
    }
    SEAM(9);
    if (IN(10)) {
        pg8::Gemm g{H, (const bf16_t*)(ws + WS_WD2), M, D, FF / 2}; pg8::StaticOrder S; S.init(M, D, G, (int)blockIdx.x);
        pg8::EpiResid<false, false, true> E{A.out, XB, nullptr, nullptr, nullptr, 0.5f / (64.0f * 4.0f), nullptr};
        pg8::gemm_phase<pg8::EpiResid<false, false, true>, pg8::StaticOrder, true, true, 0, 1>(lds, g, S, E);
    }
#undef IN
#undef SEAM
}

extern "C" void kernel_launch(void* const* d_in, const int* in_sizes, int n_in, void* d_out, int out_size, void* d_ws, size_t ws_size, hipStream_t stream) {
    static int grid = 0;
    if (grid == 0) {
        if (n_in != 21 || in_sizes[0] != M * D || out_size != M * D || ws_size < WS_END) { fprintf(stderr, "kernel_launch: unexpected shapes (n_in %d, in0 %d, out %d, ws %zu); nothing launched\n", n_in, n_in > 0 ? in_sizes[0] : -1, out_size, ws_size); grid = -1; return; }
        int dev = 0, cus = 0, per_cu = 0;
        if (hipGetDevice(&dev) != hipSuccess || hipDeviceGetAttribute(&cus, hipDeviceAttributeMultiprocessorCount, dev) != hipSuccess) { grid = -1; return; }
        if (hipFuncSetAttribute((const void*)hymba_fwd, hipFuncAttributeMaxDynamicSharedMemorySize, LDS_BYTES) != hipSuccess) { fprintf(stderr, "kernel_launch: hipFuncSetAttribute failed\n"); grid = -1; return; }
        if (hipOccupancyMaxActiveBlocksPerMultiprocessor(&per_cu, (const void*)hymba_fwd, NTHREADS, LDS_BYTES) != hipSuccess || per_cu < 1) per_cu = 1;
        (void)hipGetLastError();
        grid = cus * per_cu;
    }
    if (grid < 0) return;
    if (hipMemsetAsync((char*)d_ws + WS_BAR, 0, CTL_ZERO_BYTES, stream) != hipSuccess) { fprintf(stderr, "kernel_launch: hipMemsetAsync failed\n"); return; }
    Args a{};
    for (int i = 0; i < 21; ++i) a.in[i] = d_in[i];
    a.out = (float*)d_out; a.ws = (unsigned char*)d_ws;
    void* args[] = {&a};
    a.ph_lo = 0; a.ph_hi = NPHASE;
    hipError_t e = hipLaunchCooperativeKernel((const void*)hymba_fwd, dim3(grid), dim3(NTHREADS), args, LDS_BYTES, stream);
    if (e != hipSuccess) fprintf(stderr, "kernel_launch: cooperative launch failed: %s (grid %d)\n", hipGetErrorString(e), grid);
}
```

```cpp
#include <hip/hip_runtime.h>
#include <hip/hip_cooperative_groups.h>
#include <cstdio>
#include <cstdint>
namespace cg = cooperative_groups;
namespace pg8 {
#define PG8_LAS __attribute__((address_space(3)))
typedef unsigned short bf16_t;
typedef short bf16x8 __attribute__((ext_vector_type(8)));
typedef float f32x4 __attribute__((ext_vector_type(4)));
typedef unsigned u32x4 __attribute__((ext_vector_type(4)));
constexpr int BM = 256, BK = 64, HALF = 128, HTB = HALF * BK * 2  , STAGE_BYTES = 8 * HTB, NXCD = 8, WGM = 8;

__host__ __device__ __forceinline__ int lds_byte(int r, int c) { const int st = (r >> 4) * 2 + (c >> 5), rr = r & 15, cc = c & 31, ob = rr * 64 + cc * 2; return st * 1024 + (ob ^ (((ob >> 9) & 1) << 5)); }
__host__ __device__ __forceinline__ void stage_rc(int b, int& R, int& C) { const int st = b / 1024, sb = b % 1024, swz = sb ^ (((sb >> 9) & 1) << 5); R = (st >> 1) * 16 + swz / 64; C = (st & 1) * 32 + (swz % 64) / 2; }
__host__ __device__ __forceinline__ int perm32(int rho) { const int n = rho >> 4, i = rho & 15; return 8 * (i >> 2) + 4 * n + (i & 3); }

struct Unit { int pm, pn; };
struct Gemm { const bf16_t* A; const bf16_t* Bt; int M, N, K; };

struct StaticOrder {
    int nM, nN, nwg, G, c;
    __host__ __device__ void init(int M, int N, int G_, int c_) { nM = M / BM; nN = N / BM; nwg = nM * nN; G = G_; c = c_; }
    __host__ __device__ bool next(int i, Unit& u) const {
        const long L = (long)i * G + c; if (L >= nwg) return false;
        int wgid = (int)L; { const int q = nwg / NXCD, r = nwg % NXCD, xcd = wgid % NXCD, off = wgid / NXCD; wgid = (xcd < r ? xcd * (q + 1) : r * (q + 1) + (xcd - r) * q) + off; }
        const int nig = WGM * nN, gid = wgid / nig, fm = gid * WGM, gsz = (nM - fm) < WGM ? (nM - fm) : WGM;
        u.pm = fm + ((wgid % nig) % gsz); u.pn = (wgid % nig) / gsz; return true;
    }
    __device__ __forceinline__ void a_ready(const Unit&) const {}
    __device__ __forceinline__ void done(const Unit&) const {}
};
__device__ __forceinline__ unsigned cvt_pk_bf16(float lo, float hi) { unsigned r; asm volatile("v_cvt_pk_bf16_f32 %0, %1, %2" : "=v"(r) : "v"(lo), "v"(hi)); return r; }
typedef unsigned u32x2 __attribute__((ext_vector_type(2)));
typedef int i32x8 __attribute__((ext_vector_type(8)));
typedef int i32x4 __attribute__((ext_vector_type(4)));
__device__ __forceinline__ i32x8 cat8(const bf16x8 a, const bf16x8 b) { const i32x4 x = __builtin_bit_cast(i32x4, a), y = __builtin_bit_cast(i32x4, b); return __builtin_shufflevector(x, y, 0, 1, 2, 3, 4, 5, 6, 7); }
__device__ __forceinline__ float clamp448(float v) { return __builtin_amdgcn_fmed3f(v, -448.0f, 448.0f); }
__device__ __forceinline__ unsigned pack4_fp8(const f32x4 v) { int w = __builtin_amdgcn_cvt_pk_fp8_f32(clamp448(v[0]), clamp448(v[1]), 0, false); w = __builtin_amdgcn_cvt_pk_fp8_f32(clamp448(v[2]), clamp448(v[3]), w, true); return (unsigned)w; }
__device__ __forceinline__ float fast_rcp(float x) { return __builtin_amdgcn_rcpf(x); }
__device__ __forceinline__ float fast_exp(float x) { return __builtin_amdgcn_exp2f(x * 1.4426950408889634f); }
__device__ __forceinline__ float silu_f(float g) { return g * fast_rcp(1.0f + fast_exp(-g)); }
__device__ __forceinline__ float gelu_t(float x) { const float u = 0.7978845608028654f * (x + 0.044715f * x * x * x); return x * fast_rcp(1.0f + fast_exp(-2.0f * u)); }
__device__ __forceinline__ u32x4 pack8(const f32x4 a, const f32x4 b) { u32x4 w; w.x = cvt_pk_bf16(a[0], a[1]); w.y = cvt_pk_bf16(a[2], a[3]); w.z = cvt_pk_bf16(b[0], b[1]); w.w = cvt_pk_bf16(b[2], b[3]); return w; }
__device__ __forceinline__ float dot4(const f32x4 a) { return (a[0] * a[0] + a[1] * a[1]) + (a[2] * a[2] + a[3] * a[3]); }

template <bool F8OUT, bool I8IN = false> struct EpiSwiglu {
    static constexpr bool PERM = true, AFTER_DRAIN = false;
    bf16_t* H; const float* rs; int ldh; float hscale; const unsigned* colmax;
    __device__ __forceinline__ void mid(f32x4 (&)[2][2][4][2], const Unit&, int, int, int, int) const {}
    __device__ __forceinline__ void pre(float (&p)[8], const Unit& u, int wr, int fr) const {
#pragma unroll
        for (int i = 0; i < 8; ++i) p[i] = rs[u.pm * BM + wr * 64 + fr + (i >> 2) * HALF + (i & 3) * 16];
    }
    __device__ __forceinline__ void operator()(const f32x4 (&acc)[2][2][4][2], const Unit& u, int wr, int wc, int fr, int fq, const float (&pr)[8]) const {
        const int row0 = u.pm * BM + wr * 64 + fr, col0 = u.pn * 128 + wc * 32 + 8 * fq;
        f32x4 csg[2], csu[2];
        if constexpr (I8IN) {
#pragma unroll
            for (int n = 0; n < 2; ++n) { const u32x4 a = *(const u32x4*)(colmax + u.pn * BM + wc * 32 + 8 * fq + 4 * n), b = *(const u32x4*)(colmax + u.pn * BM + HALF + wc * 32 + 8 * fq + 4 * n);
                csg[n] = (f32x4){__uint_as_float(a.x), __uint_as_float(a.y), __uint_as_float(a.z), __uint_as_float(a.w)} * (1.0f / 127.0f);
                csu[n] = (f32x4){__uint_as_float(b.x), __uint_as_float(b.y), __uint_as_float(b.z), __uint_as_float(b.w)} * (1.0f / 127.0f); }
        }
#pragma unroll
        for (int ai = 0; ai < 2; ++ai)
#pragma unroll
            for (int m = 0; m < 4; ++m) { const int row = row0 + ai * HALF + m * 16; const float s = pr[ai * 4 + m];
                f32x4 h[2];
#pragma unroll
                for (int n = 0; n < 2; ++n) { f32x4 g, uu;
                    if constexpr (I8IN) { const i32x4 gi = __builtin_bit_cast(i32x4, acc[ai][0][m][n]), ui = __builtin_bit_cast(i32x4, acc[ai][1][m][n]);
                        g = (f32x4){(float)gi[0], (float)gi[1], (float)gi[2], (float)gi[3]} * (csg[n] * s); uu = (f32x4){(float)ui[0], (float)ui[1], (float)ui[2], (float)ui[3]} * (csu[n] * s); }
                    else { g = acc[ai][0][m][n] * s; uu = acc[ai][1][m][n] * s; }
#pragma unroll
                    for (int j = 0; j < 4; ++j) h[n][j] = silu_f(g[j]) * uu[j]; }
                if constexpr (F8OUT) { u32x2 w; w.x = pack4_fp8(h[0] * hscale); w.y = pack4_fp8(h[1] * hscale); *(u32x2*)((unsigned char*)H + (size_t)row * ldh + col0) = w; }
                else *(u32x4*)(H + (size_t)row * ldh + col0) = pack8(h[0], h[1]); }
    }
};

__device__ __forceinline__ f32x4 bflo(const u32x4 w) { return (f32x4){__uint_as_float(w.x << 16), __uint_as_float(w.x & 0xffff0000u), __uint_as_float(w.y << 16), __uint_as_float(w.y & 0xffff0000u)}; }
__device__ __forceinline__ f32x4 bfhi(const u32x4 w) { return (f32x4){__uint_as_float(w.z << 16), __uint_as_float(w.z & 0xffff0000u), __uint_as_float(w.w << 16), __uint_as_float(w.w & 0xffff0000u)}; }
template <bool ROWSCALE, bool WB, bool WF> struct EpiResid {
    static constexpr bool PERM = true, AFTER_DRAIN = false;
    float* out; bf16_t* xb; float* part; const float* rsA; const float* rsB; float alpha; float* partmax;
    __device__ __forceinline__ void pre(float (&p)[8], const Unit& u, int wr, int fr) const {
        if constexpr (ROWSCALE) {
#pragma unroll
            for (int i = 0; i < 8; ++i) p[i] = rsB[u.pm * BM + wr * 64 + fr + (i >> 2) * HALF + (i & 3) * 16];
        }
    }
    __device__ __forceinline__ void mid(f32x4 (&acc)[2][2][4][2], const Unit& u, int wr, int wc, int fr, int fq) const {
        if constexpr (ROWSCALE) {
            const int row0 = u.pm * BM + wr * 64 + fr; float r[8];
#pragma unroll
            for (int i = 0; i < 8; ++i) r[i] = rsA[row0 + (i >> 2) * HALF + (i & 3) * 16];
#pragma unroll
            for (int ai = 0; ai < 2; ++ai)
#pragma unroll
                for (int m = 0; m < 4; ++m)
#pragma unroll
                    for (int bj = 0; bj < 2; ++bj)
#pragma unroll
                        for (int n = 0; n < 2; ++n) acc[ai][bj][m][n] = acc[ai][bj][m][n] * r[ai * 4 + m];
        }
    }
    __device__ __forceinline__ void operator()(const f32x4 (&acc)[2][2][4][2], const Unit& u, int wr, int wc, int fr, int fq, const float (&pr)[8]) const {
        int row0 = u.pm * BM + wr * 64 + fr, col0 = u.pn * BM + wc * 32 + 8 * fq;
        asm volatile("" : "+v"(row0), "+v"(col0));
        constexpr int DEPTH = 8;
        u32x4 rb[16];
#pragma unroll
        for (int st = 0; st < DEPTH; ++st) rb[st] = *(const u32x4*)(xb + (size_t)(row0 + (st >> 3) * HALF + ((st >> 1) & 3) * 16) * 2048 + col0 + (st & 1) * HALF);
        float ss = 0.f, mxv = 0.f;
#pragma unroll
        for (int st = 0; st < 16; ++st) { const int ai = st >> 3, m = (st >> 1) & 3, bj = st & 1; const int row = row0 + ai * HALF + m * 16;
            float a = alpha; if constexpr (ROWSCALE) a = pr[ai * 4 + m];
            const size_t off = (size_t)row * 2048 + col0 + bj * HALF;
            const f32x4 v0 = bflo(rb[st]) + acc[ai][bj][m][0] * a, v1 = bfhi(rb[st]) + acc[ai][bj][m][1] * a;
            if constexpr (WF) { *(f32x4*)(out + off) = v0; *(f32x4*)(out + off + 4) = v1; }
            if constexpr (WB) { *(u32x4*)(xb + off) = pack8(v0, v1); ss += dot4(v0) + dot4(v1);
                if constexpr (ROWSCALE) { const f32x4 a0 = __builtin_elementwise_abs(v0), a1 = __builtin_elementwise_abs(v1); mxv = fmaxf(mxv, fmaxf(fmaxf(fmaxf(a0[0], a0[1]), fmaxf(a0[2], a0[3])), fmaxf(fmaxf(a1[0], a1[1]), fmaxf(a1[2], a1[3])))); }
                if (bj == 1) { ss += __shfl_xor(ss, 16); ss += __shfl_xor(ss, 32); if (fq == 0) part[(size_t)row * 32 + u.pn * 4 + wc] = ss; ss = 0.f;
                    if constexpr (ROWSCALE) { mxv = fmaxf(mxv, __shfl_xor(mxv, 16)); mxv = fmaxf(mxv, __shfl_xor(mxv, 32)); if (fq == 0) partmax[(size_t)row * 32 + u.pn * 4 + wc] = mxv; mxv = 0.f; } } }
            if (st + DEPTH < 16) { const int s2 = st + DEPTH; rb[s2] = *(const u32x4*)(xb + (size_t)(row0 + (s2 >> 3) * HALF + ((s2 >> 1) & 3) * 16) * 2048 + col0 + (s2 & 1) * HALF); } }
    }
};

struct EpiIn {
    static constexpr bool PERM = true, AFTER_DRAIN = false;
    bf16_t *Q, *Kb, *Vb, *GU, *GV; const float *rs2, *qn, *kn, *gvn, *cs; float* partG;
    __device__ __forceinline__ void mid(f32x4 (&)[2][2][4][2], const Unit&, int, int, int, int) const {}
    __device__ __forceinline__ void pre(float (&p)[8], const Unit& u, int wr, int fr) const {
#pragma unroll
        for (int i = 0; i < 8; ++i) p[i] = rs2[u.pm * BM + wr * 64 + fr + (i >> 2) * HALF + (i & 3) * 16];
    }
    __device__ __forceinline__ void operator()(const f32x4 (&acc)[2][2][4][2], const Unit& u, int wr, int wc, int fr, int fq, const float (&pr)[8]) const {
        const int row0 = u.pm * BM + wr * 64 + fr, pn = u.pn;
        if (pn <= 4) {
            const bool isq = pn < 4; const float* gn = isq ? qn : kn; const float osc = isq ? 0.125f * 1.4426950408889634f : 1.0f;
            bf16_t* dst = isq ? (Q + (pn * 4 + wc) * 64 + 16 * fq) : (Kb + wc * 64 + 16 * fq); const int ld = isq ? 1024 : 256;
            f32x4 gg[2][2];
#pragma unroll
            for (int bj = 0; bj < 2; ++bj)
#pragma unroll
                for (int n = 0; n < 2; ++n) gg[bj][n] = *(const f32x4*)(gn + 16 * fq + 8 * n + 4 * bj) * osc;
            f32x4 ccur[4];
#pragma unroll
            for (int q = 0; q < 4; ++q) ccur[q] = *(const f32x4*)(cs + (size_t)row0 * 16 + 4 * q);
#pragma unroll
            for (int ai = 0; ai < 2; ++ai)
#pragma unroll
                for (int m = 0; m < 4; ++m) { const int row = row0 + ai * HALF + m * 16; const float s = pr[ai * 4 + m];
                    f32x4 cnx[4];
#pragma unroll
                    for (int q = 0; q < 4; ++q) cnx[q] = ccur[q];
                    if (ai * 4 + m + 1 < 8) { const int i2 = ai * 4 + m + 1; const float* csn = cs + (size_t)(row0 + (i2 >> 2) * HALF + (i2 & 3) * 16) * 16;
#pragma unroll
                        for (int q = 0; q < 4; ++q) cnx[q] = *(const f32x4*)(csn + 4 * q); }
                    f32x4 v[2][2]; float ss = 0.f;
#pragma unroll
                    for (int bj = 0; bj < 2; ++bj)
#pragma unroll
                        for (int n = 0; n < 2; ++n) { v[bj][n] = acc[ai][bj][m][n] * s; ss += dot4(v[bj][n]); }
                    ss += __shfl_xor(ss, 16); ss += __shfl_xor(ss, 32);
                    const float rn = __builtin_amdgcn_rsqf(ss * (1.0f / 64.0f) + 1e-6f);
#pragma unroll
                    for (int bj = 0; bj < 2; ++bj)
#pragma unroll
                        for (int n = 0; n < 2; ++n) v[bj][n] = v[bj][n] * rn * gg[bj][n];
#pragma unroll
                    for (int bj = 0; bj < 2; ++bj) { const f32x4 cc = ccur[bj], sn = ccur[2 + bj];
                        const f32x4 x1 = v[bj][0], x2 = v[bj][1]; const f32x4 r1 = x1 * cc - x2 * sn, r2 = x2 * cc + x1 * sn;
                        if (fq == 0) { v[bj][0] = r1; v[bj][1] = r2; } }
                    bf16_t* p = dst + (size_t)row * ld;
                    *(u32x4*)p = pack8(v[0][0], v[1][0]); *(u32x4*)(p + 8) = pack8(v[0][1], v[1][1]);
#pragma unroll
                    for (int q = 0; q < 4; ++q) ccur[q] = cnx[q]; }
        } else if (pn == 5) {
#pragma unroll
            for (int ai = 0; ai < 2; ++ai)
#pragma unroll
                for (int m = 0; m < 4; ++m) { const int row = row0 + ai * HALF + m * 16; const float s = pr[ai * 4 + m];
#pragma unroll
                    for (int bj = 0; bj < 2; ++bj) *(u32x4*)(Vb + (size_t)row * 256 + bj * HALF + wc * 32 + 8 * fq) = pack8(acc[ai][bj][m][0] * s, acc[ai][bj][m][1] * s); }
        } else if (pn < 10) {
            const int colt = (pn - 6) * 256 + wc * 32 + 8 * fq;
#pragma unroll
            for (int ai = 0; ai < 2; ++ai)
#pragma unroll
                for (int m = 0; m < 4; ++m) { const int row = row0 + ai * HALF + m * 16; const float s = pr[ai * 4 + m];
#pragma unroll
                    for (int bj = 0; bj < 2; ++bj) { f32x4 y0 = acc[ai][bj][m][0] * s, y1 = acc[ai][bj][m][1] * s;
#pragma unroll
                        for (int j = 0; j < 4; ++j) { y0[j] = gelu_t(y0[j]); y1[j] = gelu_t(y1[j]); }
                        *(u32x4*)(GU + (size_t)row * 1024 + colt + bj * HALF) = pack8(y0, y1); } }
        } else {
            const int colt = (pn - 10) * 256 + wc * 32 + 8 * fq;
            f32x4 gg[2][2];
#pragma unroll
            for (int bj = 0; bj < 2; ++bj)
#pragma unroll
                for (int n = 0; n < 2; ++n) gg[bj][n] = *(const f32x4*)(gvn + colt + bj * HALF + 4 * n);
#pragma unroll
            for (int ai = 0; ai < 2; ++ai)
#pragma unroll
                for (int m = 0; m < 4; ++m) { const int row = row0 + ai * HALF + m * 16; const float s = pr[ai * 4 + m];
#pragma unroll
                    for (int bj = 0; bj < 2; ++bj) { f32x4 y0 = acc[ai][bj][m][0] * s, y1 = acc[ai][bj][m][1] * s;
#pragma unroll
                        for (int j = 0; j < 4; ++j) { y0[j] = gelu_t(y0[j]); y1[j] = gelu_t(y1[j]); }
                        float ss = dot4(y0) + dot4(y1); ss += __shfl_xor(ss, 16); ss += __shfl_xor(ss, 32);
                        if (fq == 0) partG[((size_t)row * 8 + (pn - 10) * 2 + bj) * 4 + wc] = ss;
                        *(u32x4*)(GV + (size_t)row * 1024 + colt + bj * HALF) = pack8(y0 * gg[bj][0], y1 * gg[bj][1]); } }
        }
    }
};

template <class Epi, class Sched, bool ALIGN_EPI = false, bool SP2 = false, int MIDK = 0, int MODE = 0>
__device__ __forceinline__ void gemm_phase(PG8_LAS unsigned char* lds, const Gemm g, const Sched& S, const Epi& E) {
    constexpr bool F8 = (MODE == 1), I8 = (MODE == 2);
    const int tid = threadIdx.x, wid = __builtin_amdgcn_readfirstlane(tid >> 6), lane = tid & 63, wr = wid >> 2, wc = wid & 3, fr = lane & 15, fq = lane >> 4;
    const int K = g.K, nt = K / BK;
    unsigned voffA[2], voffB[2];
#pragma unroll
    for (int i = 0; i < 2; ++i) { int R, C; stage_rc(tid * 16 + i * 8192, R, C); const int Rb = Epi::PERM ? ((R & ~31) + perm32(R & 31)) : R;
        voffA[i] = (unsigned)(R * K + C) * 2u; voffB[i] = (unsigned)(Rb * K + C) * 2u; }
    const size_t kstep = (size_t)(BK * 2);
    const size_t hstep = (size_t)HALF * K * 2;
    const size_t tstep = 2 * hstep;
    const unsigned ldsw = (unsigned)wid * 1024u;
    const int kc0 = F8 ? (32 * (fq >> 1) + 16 * (fq & 1)) : fq * 8;
    constexpr int KPIECE = F8 ? 16 : 1024;
    const int aoff = lds_byte(wr * 64 + fr, kc0), boff = lds_byte(wc * 32 + fr, kc0);
#define PG8_SA(b, h) (((b) * 2 + (h)) * HTB)
#define PG8_SB(b, h) ((4 + (b) * 2 + (h)) * HTB)
#define PG8_STAGE(bufoff, gbase, voff) do { _Pragma("unroll") for (int _i = 0; _i < 2; ++_i) \
        __builtin_amdgcn_global_load_lds((const unsigned*)((const char*)(gbase) + (voff)[_i]), (PG8_LAS unsigned*)(lds + (bufoff) + ldsw + _i * 8192), 16, 0, 0); } while (0)
#define PG8_LDA(dst, b, h) do { _Pragma("unroll") for (int m = 0; m < 4; ++m) { \
        if constexpr (F8) dst##8[m] = cat8(*(const PG8_LAS bf16x8*)(lds + PG8_SA(b, h) + aoff + m * 2048), *(const PG8_LAS bf16x8*)(lds + PG8_SA(b, h) + aoff + m * 2048 + KPIECE)); \
        else { _Pragma("unroll") for (int k = 0; k < 2; ++k) dst[m][k] = *(const PG8_LAS bf16x8*)(lds + PG8_SA(b, h) + aoff + m * 2048 + k * KPIECE); } } } while (0)
#define PG8_LDB(dst, b, h) do { _Pragma("unroll") for (int n = 0; n < 2; ++n) { \
        if constexpr (F8) dst##8[n] = cat8(*(const PG8_LAS bf16x8*)(lds + PG8_SB(b, h) + boff + n * 2048), *(const PG8_LAS bf16x8*)(lds + PG8_SB(b, h) + boff + n * 2048 + KPIECE)); \
        else { _Pragma("unroll") for (int k = 0; k < 2; ++k) dst[n][k] = *(const PG8_LAS bf16x8*)(lds + PG8_SB(b, h) + boff + n * 2048 + k * KPIECE); } } } while (0)
#define PG8_MMA(ai, bj, At, Bt) do { __builtin_amdgcn_s_setprio(1); _Pragma("unroll") for (int m = 0; m < 4; ++m) _Pragma("unroll") for (int n = 0; n < 2; ++n) { \
        if constexpr (F8) asm volatile("v_mfma_f32_16x16x128_f8f6f4 %0, %1, %2, %0" : "+v"(acc[ai][bj][m][n]) : "v"(Bt##8[n]), "v"(At##8[m]));   \
        else if constexpr (I8) { _Pragma("unroll") for (int k = 0; k < 2; ++k) acc[ai][bj][m][n] = __builtin_bit_cast(f32x4, __builtin_amdgcn_mfma_i32_16x16x64_i8(__builtin_bit_cast(i32x4, Bt[n][k]), __builtin_bit_cast(i32x4, At[m][k]), __builtin_bit_cast(i32x4, acc[ai][bj][m][n]), 0, 0, 0)); } \
        else { _Pragma("unroll") for (int k = 0; k < 2; ++k) acc[ai][bj][m][n] = __builtin_amdgcn_mfma_f32_16x16x32_bf16(Bt[n][k], At[m][k], acc[ai][bj][m][n], 0, 0, 0); } } __builtin_amdgcn_s_setprio(0); } while (0)
#define PG8_WAIT_V(n) asm volatile("s_waitcnt vmcnt(" #n ")" ::: "memory")
#define PG8_WAIT_L(n) asm volatile("s_waitcnt lgkmcnt(" #n ")" ::: "memory")
#define PG8_BAR __builtin_amdgcn_s_barrier()
#define PG8_SCHED __builtin_amdgcn_sched_barrier(0)
    Unit cur, nxt; int ui = 0;
    if (!S.next(0, cur)) return;
    f32x4 acc[2][2][4][2];
#pragma unroll
    for (int a = 0; a < 2; ++a)
#pragma unroll
        for (int b = 0; b < 2; ++b)
#pragma unroll
            for (int m = 0; m < 4; ++m)
#pragma unroll
                for (int n = 0; n < 2; ++n) acc[a][b][m][n] = (f32x4){0.f, 0.f, 0.f, 0.f};
    bf16x8 At[4][2], B0[2][2], B1[2][2]; i32x8 At8[4], B08[2], B18[2];
    float pre[8];
#pragma unroll
    for (int i = 0; i < 8; ++i) pre[i] = 0.f;
    const char* cA = (const char*)g.A + (size_t)cur.pm * tstep; const char* cB = (const char*)g.Bt + (size_t)cur.pn * tstep;
    S.a_ready(cur);
    if constexpr (SP2) {
        PG8_STAGE(PG8_SB(0, 0), cB, voffB); PG8_STAGE(PG8_SB(0, 1), cB + hstep, voffB); PG8_STAGE(PG8_SA(0, 0), cA, voffA); PG8_STAGE(PG8_SA(0, 1), cA + hstep, voffA);
        if (wr == 1) PG8_BAR;
        PG8_WAIT_V(2); PG8_BAR;
        PG8_STAGE(PG8_SB(1, 0), cB + kstep, voffB); PG8_STAGE(PG8_SA(1, 0), cA + kstep, voffA); PG8_STAGE(PG8_SB(1, 1), cB + hstep + kstep, voffB);
        PG8_WAIT_V(6); PG8_BAR;
    } else {
        PG8_STAGE(PG8_SB(0, 0), cB, voffB); PG8_STAGE(PG8_SA(0, 0), cA, voffA); PG8_STAGE(PG8_SB(0, 1), cB + hstep, voffB); PG8_STAGE(PG8_SA(0, 1), cA + hstep, voffA);
        if (wr == 1) PG8_BAR;
        PG8_WAIT_V(4); PG8_BAR;
        PG8_STAGE(PG8_SB(1, 0), cB + kstep, voffB); PG8_STAGE(PG8_SA(1, 0), cA + kstep, voffA); PG8_STAGE(PG8_SB(1, 1), cB + hstep + kstep, voffB);
        PG8_WAIT_V(6); PG8_BAR;
    }
    for (;;) {
        const bool has_next = S.next(ui + 1, nxt);
        const char* nA = has_next ? (const char*)g.A + (size_t)nxt.pm * tstep : cA; const char* nB = has_next ? (const char*)g.Bt + (size_t)nxt.pn * tstep : cB;
        for (int t = 0; t < nt; t += 2) {
            const bool last = (t == nt - 2);
            const char* a1 = cA + (size_t)(t + 1) * kstep;
            const char* a2 = last ? nA : cA + (size_t)(t + 2) * kstep; const char* b2 = last ? nB : cB + (size_t)(t + 2) * kstep;
            const char* a3 = a2 + kstep; const char* b3 = b2 + kstep;
            if (last && has_next) S.a_ready(nxt);
            if (last) E.pre(pre, cur, wr, fr);
            if constexpr (MIDK > 0) { if (t == MIDK / BK) E.mid(acc, cur, wr, wc, fr, fq); }
            if constexpr (SP2) {
            PG8_LDB(B0, 0, 0); PG8_LDB(B1, 0, 1); PG8_SCHED; PG8_LDA(At, 0, 0); PG8_STAGE(PG8_SA(1, 1), a1 + hstep, voffA);
            PG8_WAIT_V(8); PG8_WAIT_L(0); PG8_BAR; PG8_MMA(0, 0, At, B0); PG8_MMA(0, 1, At, B1); PG8_BAR; PG8_SCHED;
            PG8_LDA(At, 0, 1); PG8_STAGE(PG8_SB(0, 0), b2, voffB); PG8_STAGE(PG8_SB(0, 1), b2 + hstep, voffB); PG8_STAGE(PG8_SA(0, 0), a2, voffA);
            PG8_WAIT_V(8); PG8_WAIT_L(0); PG8_BAR; PG8_MMA(1, 0, At, B0); PG8_MMA(1, 1, At, B1); PG8_BAR; PG8_SCHED;
            PG8_LDB(B0, 1, 0); PG8_LDB(B1, 1, 1); PG8_SCHED; PG8_LDA(At, 1, 0); PG8_STAGE(PG8_SA(0, 1), a2 + hstep, voffA);
            PG8_WAIT_V(8); PG8_WAIT_L(0); PG8_BAR; PG8_MMA(0, 0, At, B0); PG8_MMA(0, 1, At, B1); PG8_BAR; PG8_SCHED;
            PG8_LDA(At, 1, 1); PG8_STAGE(PG8_SB(1, 0), b3, voffB); PG8_STAGE(PG8_SB(1, 1), b3 + hstep, voffB); PG8_STAGE(PG8_SA(1, 0), a3, voffA);
            PG8_WAIT_V(8); PG8_WAIT_L(0); PG8_BAR; PG8_MMA(1, 0, At, B0); PG8_MMA(1, 1, At, B1); PG8_BAR; PG8_SCHED;
            } else {
            PG8_LDB(B0, 0, 0); PG8_SCHED; PG8_LDA(At, 0, 0); PG8_STAGE(PG8_SA(1, 1), a1 + hstep, voffA);
            PG8_WAIT_L(8); PG8_BAR; PG8_WAIT_L(0); PG8_MMA(0, 0, At, B0); PG8_BAR; PG8_SCHED;
            PG8_LDB(B1, 0, 1); PG8_STAGE(PG8_SB(0, 0), b2, voffB);
            PG8_BAR; PG8_WAIT_L(0); PG8_MMA(0, 1, At, B1); PG8_BAR;
            PG8_LDA(At, 0, 1); PG8_STAGE(PG8_SA(0, 0), a2, voffA);
            PG8_BAR; PG8_WAIT_L(0); PG8_MMA(1, 0, At, B0); PG8_BAR; PG8_SCHED;
            PG8_STAGE(PG8_SB(0, 1), b2 + hstep, voffB);
            PG8_WAIT_V(6); PG8_BAR; PG8_MMA(1, 1, At, B1); PG8_BAR;
            PG8_LDB(B0, 1, 0); PG8_SCHED; PG8_LDA(At, 1, 0); PG8_STAGE(PG8_SA(0, 1), a2 + hstep, voffA);
            PG8_WAIT_L(8); PG8_BAR; PG8_WAIT_L(0); PG8_MMA(0, 0, At, B0); PG8_BAR; PG8_SCHED;
            PG8_LDB(B1, 1, 1); PG8_STAGE(PG8_SB(1, 0), b3, voffB);
            PG8_BAR; PG8_WAIT_L(0); PG8_MMA(0, 1, At, B1); PG8_BAR;
            PG8_LDA(At, 1, 1); PG8_STAGE(PG8_SA(1, 0), a3, voffA);
            PG8_BAR; PG8_WAIT_L(0); PG8_MMA(1, 0, At, B0); PG8_BAR; PG8_SCHED;
            PG8_STAGE(PG8_SB(1, 1), b3 + hstep, voffB);
            PG8_WAIT_V(6); PG8_BAR; PG8_MMA(1, 1, At, B1); PG8_BAR;
            }
        }
        if constexpr (F8) asm volatile("s_nop 15\n\ts_nop 15" ::: "memory");
        if constexpr (ALIGN_EPI) { if (wr == 0) PG8_BAR; }
        if constexpr (!Epi::AFTER_DRAIN) { E(acc, cur, wr, wc, fr, fq, pre); S.done(cur); }
        if (!has_next) break;
#pragma unroll
        for (int a = 0; a < 2; ++a)
#pragma unroll
            for (int b = 0; b < 2; ++b)
#pragma unroll
                for (int m = 0; m < 4; ++m)
#pragma unroll
                    for (int n = 0; n < 2; ++n) acc[a][b][m][n] = (f32x4){0.f, 0.f, 0.f, 0.f};
        cur = nxt; cA = nA; cB = nB; ++ui;
        if constexpr (ALIGN_EPI) { if (wr == 1) PG8_BAR; }
    }
    PG8_WAIT_V(0);
    if constexpr (!ALIGN_EPI) { if (wr == 0) PG8_BAR; }
    PG8_BAR;
    if constexpr (Epi::AFTER_DRAIN) { E.fused(acc, cur, wr, wc, fr, fq, lds, wid, lane); S.done(cur); }
#undef PG8_SA
#undef PG8_SB
#undef PG8_STAGE
#undef PG8_LDA
#undef PG8_LDB
#undef PG8_MMA
#undef PG8_WAIT_V
#undef PG8_WAIT_L
#undef PG8_BAR
#undef PG8_SCHED
}
}

constexpr int NWAVES = 8, NTHREADS = 512;
constexpr int BATCH = 2, SEQ = 16384, D = 2048, FF = 5632, NGU = 2 * FF, NIN = 3584;
constexpr int M = BATCH * SEQ;
constexpr float EPS = 1e-6f;
constexpr size_t MiB = 1u << 20;
constexpr size_t WS_WGU1 = 0, WS_WD1 = 44 * MiB, WS_WIN = 66 * MiB, WS_WOUT = 80 * MiB, WS_WGU2 = 88 * MiB, WS_WD2 = 132 * MiB;
constexpr size_t WS_WSB = 154 * MiB;
constexpr size_t WS_CS = 155 * MiB;
constexpr size_t WS_RS = 157 * MiB;
constexpr size_t WS_BAR = 157 * MiB + 768 * 1024;
constexpr size_t WS_PART = 158 * MiB;
constexpr size_t WS_PARTA = 162 * MiB;
constexpr size_t WS_PARTB = 164 * MiB;
constexpr size_t WS_PARTG = 165 * MiB;
constexpr size_t WS_XB = 170 * MiB;
constexpr size_t WS_H = 298 * MiB;
constexpr size_t WS_Q = WS_H, WS_K = WS_H + 64 * MiB, WS_V = WS_H + 80 * MiB, WS_GU = WS_H + 96 * MiB, WS_GV = WS_H + 160 * MiB, WS_AO = WS_H + 224 * MiB;
constexpr size_t WS_WGU2Q = WS_H + 352 * MiB;
constexpr size_t WS_AQ = WS_WGU2Q + 24 * MiB;
constexpr size_t WS_CMAX1 = WS_BAR + 16384, WS_CMAX2 = WS_CMAX1 + 45056;
constexpr size_t CTL_ZERO_BYTES = 16384 + 2 * 45056;
constexpr size_t WS_PMAX = WS_AQ + 64 * MiB;
constexpr size_t WS_WGU1Q = WS_PMAX + 4 * MiB;
constexpr size_t WS_END = WS_WGU1Q + 24 * MiB;
static_assert((size_t)M * FF * 2 == 352 * MiB && (size_t)M * D * 2 == 128 * MiB, "ws map");
constexpr int LDS_BYTES = 147456;

#define LAS __attribute__((address_space(3)))
typedef unsigned short bf16_t;
typedef short bf16x8 __attribute__((ext_vector_type(8)));
typedef float f32x4 __attribute__((ext_vector_type(4)));
typedef unsigned u32x4 __attribute__((ext_vector_type(4)));
typedef unsigned u32x2 __attribute__((ext_vector_type(2)));
using pg8::cvt_pk_bf16;
__device__ __forceinline__ float bf2f(unsigned b) { return __uint_as_float(b << 16); }
__device__ __forceinline__ float wave_sum(float v) {
#pragma unroll
    for (int o = 1; o < 64; o <<= 1) v += __shfl_xor(v, o);
    return v;
}

__device__ __forceinline__ int dest_row(int mode, int n) {
    if (mode == 0) return n;
    if (mode == 1) return ((n >> 7) << 8) + (n & 127);
    if (mode == 2) return ((n >> 7) << 8) + 128 + (n & 127);
    const int tile = n >> 8; if (tile > 4) return n;
    const int l = n & 255, wc = l >> 6, d = l & 63, fq = d >> 4, nn = (d >> 3) & 1, bj = (d >> 2) & 1, j = d & 3;
    return (tile << 8) + 128 * bj + 32 * wc + 8 * fq + 4 * nn + j;
}
template <bool HASG, bool F8OUT = false, bool TRACKMAX = false> __device__ __forceinline__ void transpose_item(const float* W, int K, int N, const float* g0, const float* g1, int gsplit, bf16_t* WT, int mode, LAS float* scr, int item, int lane, unsigned* wmaxp = nullptr) {
    const int nblk = N / 32, kb = item / nblk, nb = item % nblk, k0 = 64 * kb, n0 = 32 * nb; float mx = 0.f;
#pragma unroll 8
    for (int i = 0; i < 32; ++i) { const int kk = 2 * i + (lane >> 5), k = k0 + kk; float gk = 1.0f; if constexpr (HASG) gk = (k < gsplit) ? g0[k] : g1[k - gsplit];
        const float wv = W[(size_t)k * N + n0 + (lane & 31)] * gk; scr[kk * 33 + (lane & 31)] = wv; if constexpr (TRACKMAX) mx = fmaxf(mx, fabsf(wv)); }
    if constexpr (TRACKMAX) {
        mx = fmaxf(mx, __shfl_xor(mx, 32));
        if (lane < 32) __hip_atomic_fetch_max(wmaxp + dest_row(mode, n0 + lane), __float_as_uint(mx), __ATOMIC_RELAXED, __HIP_MEMORY_SCOPE_AGENT); }
    asm volatile("s_waitcnt lgkmcnt(0)" ::: "memory");
    const int c = lane & 7;
#pragma unroll
    for (int j = 0; j < 4; ++j) { const int n = (lane >> 3) + 8 * j; const LAS float* s = scr + (8 * c) * 33 + n;
        u32x4 o; o.x = cvt_pk_bf16(s[0 * 33], s[1 * 33]); o.y = cvt_pk_bf16(s[2 * 33], s[3 * 33]); o.z = cvt_pk_bf16(s[4 * 33], s[5 * 33]); o.w = cvt_pk_bf16(s[6 * 33], s[7 * 33]);
        if constexpr (F8OUT) { const f32x4 lo = (f32x4){s[0 * 33], s[1 * 33], s[2 * 33], s[3 * 33]} * 64.0f, hi = (f32x4){s[4 * 33], s[5 * 33], s[6 * 33], s[7 * 33]} * 64.0f;
            u32x2 o8; o8.x = pg8::pack4_fp8(lo); o8.y = pg8::pack4_fp8(hi); *(u32x2*)((unsigned char*)WT + (size_t)dest_row(mode, n0 + n) * K + k0 + 8 * c) = o8; }
        else *(u32x4*)(WT + (size_t)dest_row(mode, n0 + n) * K + k0 + 8 * c) = o; }
    asm volatile("s_waitcnt lgkmcnt(0)" ::: "memory");
}

struct Args { const void* in[21]; float* out; unsigned char* ws; int ph_lo, ph_hi; };

__device__ __forceinline__ void p0_prologue(const Args& A, LAS unsigned char* lds, int tid) {
    const int lane = tid & 63, wave = tid >> 6;
    LAS float* scr = (LAS float*)(lds + wave * 16384);
    const int gw = blockIdx.x * NWAVES + wave, NGW = gridDim.x * NWAVES;
    unsigned char* ws = A.ws;
    constexpr int I_G = (D / 64) * (FF / 32), I_DN = (FF / 64) * (D / 32), I_IN = (D / 64) * (NIN / 32), I_O = (D / 64) * (D / 32);
    constexpr int NITEMS = 4 * I_G + 2 * I_DN + I_IN + I_O;
    for (int it = gw; it < NITEMS; it += NGW) {
        int r = it;
        if (r < I_G) { transpose_item<true, false, true>((const float*)A.in[3], D, FF, (const float*)A.in[2], (const float*)A.in[2], 1 << 30, (bf16_t*)(ws + WS_WGU1), 1, scr, r, lane, (unsigned*)(ws + WS_CMAX1)); continue; } r -= I_G;
        if (r < I_G) { transpose_item<true, false, true>((const float*)A.in[4], D, FF, (const float*)A.in[2], (const float*)A.in[2], 1 << 30, (bf16_t*)(ws + WS_WGU1), 2, scr, r, lane, (unsigned*)(ws + WS_CMAX1)); continue; } r -= I_G;
        if (r < I_DN) { transpose_item<false>((const float*)A.in[5], FF, D, nullptr, nullptr, 0, (bf16_t*)(ws + WS_WD1), 0, scr, r, lane); continue; } r -= I_DN;
        if (r < I_IN) { transpose_item<true>((const float*)A.in[7], D, NIN, (const float*)A.in[6], (const float*)A.in[6], 1 << 30, (bf16_t*)(ws + WS_WIN), 3, scr, r, lane); continue; } r -= I_IN;
        if (r < I_O) { transpose_item<true>((const float*)A.in[16], D, D, (const float*)A.in[14], (const float*)A.in[15], 1024, (bf16_t*)(ws + WS_WOUT), 0, scr, r, lane); continue; } r -= I_O;
        if (r < I_G) { transpose_item<true, false, true>((const float*)A.in[18], D, FF, (const float*)A.in[17], (const float*)A.in[17], 1 << 30, (bf16_t*)(ws + WS_WGU2), 1, scr, r, lane, (unsigned*)(ws + WS_CMAX2)); continue; } r -= I_G;
        if (r < I_G) { transpose_item<true, false, true>((const float*)A.in[19], D, FF, (const float*)A.in[17], (const float*)A.in[17], 1 << 30, (bf16_t*)(ws + WS_WGU2), 2, scr, r, lane, (unsigned*)(ws + WS_CMAX2)); continue; } r -= I_G;
        transpose_item<false, true>((const float*)A.in[20], FF, D, nullptr, nullptr, 0, (bf16_t*)(ws + WS_WD2), 0, scr, r, lane);
    }
    const float* x = (const float*)A.in[0]; bf16_t* XB = (bf16_t*)(ws + WS_XB); float* rs1 = (float*)(ws + WS_RS);
    f32x4 vnx[8];
    if (gw < M) {
#pragma unroll
        for (int j = 0; j < 8; ++j) vnx[j] = ((const f32x4*)(x + (size_t)gw * D) + lane)[64 * j]; }
    for (int m = gw; m < M; m += NGW) {
        u32x2* o = (u32x2*)(XB + (size_t)m * D) + lane; unsigned* oq = (unsigned*)(ws + WS_AQ + (size_t)m * D) + lane; float s = 0.f, mx = 0.f;
        f32x4 v[8];
#pragma unroll
        for (int j = 0; j < 8; ++j) v[j] = vnx[j];
        if (m + NGW < M) {
#pragma unroll
            for (int j = 0; j < 8; ++j) vnx[j] = ((const f32x4*)(x + (size_t)(m + NGW) * D) + lane)[64 * j]; }
#pragma unroll
        for (int j = 0; j < 8; ++j) { s += pg8::dot4(v[j]); const f32x4 a = __builtin_elementwise_abs(v[j]); mx = fmaxf(mx, fmaxf(fmaxf(a[0], a[1]), fmaxf(a[2], a[3])));
            u32x2 w; w.x = cvt_pk_bf16(v[j][0], v[j][1]); w.y = cvt_pk_bf16(v[j][2], v[j][3]); o[64 * j] = w; }
        s = wave_sum(s);
#pragma unroll
        for (int of = 1; of < 64; of <<= 1) mx = fmaxf(mx, __shfl_xor(mx, of));
        mx = fmaxf(mx, 1e-30f); const float qs = 127.0f / mx;
#pragma unroll
        for (int j = 0; j < 8; ++j) { const f32x4 q = v[j] * qs;
            oq[64 * j] = ((unsigned)(int)__builtin_rintf(q[0]) & 0xffu) | (((unsigned)(int)__builtin_rintf(q[1]) & 0xffu) << 8) | (((unsigned)(int)__builtin_rintf(q[2]) & 0xffu) << 16) | (((unsigned)(int)__builtin_rintf(q[3]) & 0xffu) << 24); }
        if (lane == 0) rs1[m] = __builtin_amdgcn_rsqf(s * (1.0f / D) + EPS) * mx * (1.0f / 127.0f);
    }
    const int gt = blockIdx.x * NTHREADS + tid, NGT = gridDim.x * NTHREADS;
    const float* wsp = (const float*)A.in[12]; bf16_t* WSB = (bf16_t*)(ws + WS_WSB);
    for (int i = gt; i < 8 * 128 * 128 / 2; i += NGT) { const int e = 2 * i, s = e & 127, t = (e >> 7) & 127;
        const float a = (s <= t) ? wsp[e] : 0.f, b = (s + 1 <= t) ? wsp[e + 1] : 0.f; ((unsigned*)WSB)[i] = cvt_pk_bf16(a, b); }
    const int* pos = (const int*)A.in[1]; float* cs = (float*)(ws + WS_CS);
    for (int i = gt; i < M * 8; i += NGT) { const int m = i >> 3, f = i & 7;
        float invf = 1.0f;
        invf = f == 1 ? 0.19392274f : invf; invf = f == 2 ? 0.03760603f : invf; invf = f == 3 ? 0.0072926646f : invf; invf = f == 4 ? 0.0014142136f : invf;
        invf = f == 5 ? 0.0002742482f : invf; invf = f == 6 ? 5.3182957e-05f : invf; invf = f == 7 ? 1.0313385e-05f : invf;
        const float ang = (float)pos[m] * invf;
        const double rev = (double)ang * 0.15915494309189535; const float fr = (float)(rev - __builtin_rint(rev));
        cs[(size_t)m * 16 + f] = __builtin_amdgcn_cosf(fr); cs[(size_t)m * 16 + 8 + f] = __builtin_amdgcn_sinf(fr); }
}

__device__ __forceinline__ unsigned q8pair(unsigned w, float sc) {
    const int a = (int)__builtin_rintf(__builtin_amdgcn_fmed3f(bf2f(w & 0xffffu) * sc, -127.0f, 127.0f)), b = (int)__builtin_rintf(__builtin_amdgcn_fmed3f(bf2f(w >> 16) * sc, -127.0f, 127.0f));
    return ((unsigned)a & 0xffu) | (((unsigned)b & 0xffu) << 8);
}
__device__ __forceinline__ u32x2 q8x8(const u32x4 w, float sc) { u32x2 o; o.x = q8pair(w.x, sc) | (q8pair(w.y, sc) << 16); o.y = q8pair(w.z, sc) | (q8pair(w.w, sc) << 16); return o; }
__device__ __forceinline__ void quantize_wgu(const unsigned char* srcb, unsigned char* dstb, const unsigned* cmax, int tid) {
    const u32x4* src = (const u32x4*)srcb; u32x2* dst = (u32x2*)dstb;
    constexpr int NU = 8, TOTAL = NGU * D / 8;
    const int stride = gridDim.x * NTHREADS;
    for (int i0 = blockIdx.x * NTHREADS + tid; i0 < TOTAL; i0 += NU * stride) {
        u32x4 v[NU]; unsigned cm[NU];
#pragma unroll
        for (int u = 0; u < NU; ++u) { const int i = i0 + u * stride; const int ii = i < TOTAL ? i : i0; v[u] = src[ii]; cm[u] = __hip_atomic_load(cmax + (ii >> 8), __ATOMIC_RELAXED, __HIP_MEMORY_SCOPE_AGENT); }
#pragma unroll
        for (int u = 0; u < NU; ++u) { const int i = i0 + u * stride; if (i < TOTAL) dst[i] = q8x8(v[u], 127.0f / fmaxf(__uint_as_float(cm[u]), 1e-30f)); }
    }
}
__device__ __forceinline__ void quantize_x2(unsigned char* ws, const float* part, float* rowfac, int tid) {
    const int lane = tid & 63, gw = blockIdx.x * NWAVES + (tid >> 6), NGW = gridDim.x * NWAVES;
    const bf16_t* XB = (const bf16_t*)(ws + WS_XB); unsigned char* AQ = ws + WS_AQ; const float* pmax = (const float*)(ws + WS_PMAX);
    constexpr int NR = 4;
    for (int m0 = gw; m0 < M; m0 += NR * NGW) {
        float p[NR], mx[NR]; u32x4 v[NR][4];
#pragma unroll
        for (int r = 0; r < NR; ++r) { const int m = m0 + r * NGW; const bool ok = m < M; const size_t mm = ok ? (size_t)m : 0;
            p[r] = (lane < 32) ? part[mm * 32 + lane] : 0.f; mx[r] = (lane < 32) ? pmax[mm * 32 + lane] : 0.f;
            const u32x4* src = (const u32x4*)(XB + mm * D) + lane;
#pragma unroll
            for (int j = 0; j < 4; ++j) v[r][j] = src[64 * j]; }
#pragma unroll
        for (int r = 0; r < NR; ++r) { const int m = m0 + r * NGW; if (m >= M) break;
            const float ps = wave_sum(p[r]); float mxr = mx[r];
#pragma unroll
            for (int of = 1; of < 64; of <<= 1) mxr = fmaxf(mxr, __shfl_xor(mxr, of));
            mxr = fmaxf(mxr, 1e-30f); const float sc = 127.0f / mxr;
            u32x2* dst = (u32x2*)(AQ + (size_t)m * D) + lane;
#pragma unroll
            for (int j = 0; j < 4; ++j) dst[64 * j] = q8x8(v[r][j], sc);
            if (lane == 0) rowfac[m] = __builtin_amdgcn_rsqf(ps * (1.0f / D) + EPS) * mxr * (1.0f / 127.0f); }
    }
}
template <int NP> __device__ __forceinline__ void rs_finalize(const float* part, float* rs, float inv_width, int tid) {
    for (int m = blockIdx.x * NTHREADS + tid; m < M; m += gridDim.x * NTHREADS) { const f32x4* p = (const f32x4*)(part + (size_t)m * NP); float s = 0.f;
#pragma unroll
        for (int j = 0; j < NP / 4; ++j) { const f32x4 v = p[j]; s += (v[0] + v[1]) + (v[2] + v[3]); }
        rs[m] = __builtin_amdgcn_rsqf(s * inv_width + EPS); }
}

constexpr int KS_STRIDE = 144, VT_OFF = 256 * KS_STRIDE, VT_STRIDE = 528, ATT_BUF = VT_OFF + 64 * VT_STRIDE;
static_assert(2 * ATT_BUF <= LDS_BYTES, "two attention staging buffers");
struct AttnKV { u32x4 k[4], va[2], vb[2]; };
__device__ __forceinline__ void attn_load(AttnKV& R, bf16x8 (&q)[8], int au, const bf16_t* Qg, const bf16_t* Kg, const bf16_t* Vg, int tid) {
    const int wid = tid >> 6, lane = tid & 63, fr = lane & 15, fq = lane >> 4;
    const int b = au >> 9, blk = (au >> 2) & 127, kvh = au & 3;
    const int tok0 = b * SEQ + blk * 128;
#pragma unroll
    for (int it = 0; it < 4; ++it) { const int c = it * NTHREADS + tid, key = c >> 3, dc = c & 7;
        u32x4 v = (u32x4){0u, 0u, 0u, 0u};
        if (blk > 0 || key >= 128) v = *(const u32x4*)(Kg + (size_t)(tok0 - 128 + key) * 256 + kvh * 64 + dc * 8);
        R.k[it] = v; }
#pragma unroll
    for (int it = 0; it < 2; ++it) { const int task = it * NTHREADS + tid, p = task & 127, dc = task >> 7, key0 = 2 * p;
        u32x4 a = (u32x4){0u, 0u, 0u, 0u}, bb = a;
        if (blk > 0 || key0 >= 128) { const bf16_t* src = Vg + (size_t)(tok0 - 128 + key0) * 256 + kvh * 64 + dc * 8; a = *(const u32x4*)src; bb = *(const u32x4*)(src + 256); }
        R.va[it] = a; R.vb[it] = bb; }
    const int hq = kvh * 4 + (wid >> 1), i0 = (wid & 1) * 64;
#pragma unroll
    for (int s = 0; s < 4; ++s) { const bf16_t* qp = Qg + (size_t)(tok0 + i0 + 16 * s + fr) * 1024 + hq * 64 + fq * 8; q[2 * s] = *(const bf16x8*)qp; q[2 * s + 1] = *(const bf16x8*)(qp + 32); }
}
__device__ __forceinline__ void attn_store_lds(const AttnKV& R, LAS unsigned char* lds, int tid) {
#pragma unroll
    for (int it = 0; it < 4; ++it) { const int c = it * NTHREADS + tid, key = c >> 3, dc = c & 7; *(LAS u32x4*)(lds + key * KS_STRIDE + dc * 16) = R.k[it]; }
#pragma unroll
    for (int it = 0; it < 2; ++it) { const int task = it * NTHREADS + tid, p = task & 127, dc = task >> 7;
#pragma unroll
        for (int i = 0; i < 4; ++i) { const unsigned wa = R.va[it][i], wb = R.vb[it][i];
            *(LAS unsigned*)(lds + VT_OFF + (dc * 8 + 2 * i) * VT_STRIDE + p * 4) = (wa & 0xffffu) | (wb << 16);
            *(LAS unsigned*)(lds + VT_OFF + (dc * 8 + 2 * i + 1) * VT_STRIDE + p * 4) = (wa >> 16) | (wb & 0xffff0000u); } }
}
__device__ __forceinline__ void attn_compute(LAS unsigned char* lds, int au, const bf16x8 (&q)[8], bf16_t* AO, float* partA, const float sink, int tid) {
    const int wid = __builtin_amdgcn_readfirstlane(tid >> 6), lane = tid & 63, fr = lane & 15, fq = lane >> 4;
    const int b = au >> 9, blk = (au >> 2) & 127, kvh = au & 3;
    const int tok0 = b * SEQ + blk * 128;
    const int g = wid >> 1, i0 = (wid & 1) * 64, hq = kvh * 4 + g;
#pragma unroll
    for (int s = 0; s < 4; ++s) {
        const int qi = i0 + 16 * s + fr;
        const bf16x8 q0 = q[2 * s], q1 = q[2 * s + 1];
        const int T0e = ((i0 >> 4) + s) & ~1;
        f32x4 sc[10];
#pragma unroll
        for (int tt = 0; tt < 10; ++tt) { const int rel = 16 * tt - 16 * (s & 1);
            if (rel < 0 || rel > 128) { sc[tt] = (f32x4){0.f, 0.f, 0.f, 0.f}; continue; }
            const LAS unsigned char* kp = lds + (16 * (T0e + tt) + fr) * KS_STRIDE + fq * 16;
            const bf16x8 k0 = *(const LAS bf16x8*)kp, k1 = *(const LAS bf16x8*)(kp + 64);
            f32x4 a = (f32x4){0.f, 0.f, 0.f, 0.f};
            a = __builtin_amdgcn_mfma_f32_16x16x32_bf16(k0, q0, a, 0, 0, 0); a = __builtin_amdgcn_mfma_f32_16x16x32_bf16(k1, q1, a, 0, 0, 0); sc[tt] = a; }
        float mx = -1e30f;
#pragma unroll
        for (int tt = 0; tt < 10; ++tt) { const int rel = 16 * tt - 16 * (s & 1);
            if (rel < 0 || rel > 128) continue;
            if (rel >= 16 && rel <= 112) { const bool tv = (blk > 0) || (T0e + tt >= 8);
#pragma unroll
                for (int j = 0; j < 4; ++j) { const float v = tv ? sc[tt][j] : -1e30f; sc[tt][j] = v; mx = fmaxf(mx, v); } }
            else {
#pragma unroll
                for (int j = 0; j < 4; ++j) { const int kj = 16 * (T0e + tt) + 4 * fq + j, diff = qi + 128 - kj;
                    const bool valid = (diff >= 0) && (diff < 128) && (blk > 0 || kj >= 128);
                    const float v = valid ? sc[tt][j] : -1e30f; sc[tt][j] = v; mx = fmaxf(mx, v); } } }
        mx = fmaxf(mx, __shfl_xor(mx, 16)); mx = fmaxf(mx, __shfl_xor(mx, 32)); mx = fmaxf(mx, sink);
        float l = 0.f;
#pragma unroll
        for (int tt = 0; tt < 10; ++tt) { const int rel = 16 * tt - 16 * (s & 1);
            if (rel < 0 || rel > 128) continue;
#pragma unroll
            for (int j = 0; j < 4; ++j) { const float p = __builtin_amdgcn_exp2f(sc[tt][j] - mx); sc[tt][j] = p; l += p; } }
        l += __shfl_xor(l, 16); l += __shfl_xor(l, 32); l += __builtin_amdgcn_exp2f(sink - mx);
        f32x4 o[4];
#pragma unroll
        for (int dt = 0; dt < 4; ++dt) o[dt] = (f32x4){0.f, 0.f, 0.f, 0.f};
#pragma unroll
        for (int u = 0; u < 5; ++u) { const u32x4 pw = pg8::pack8(sc[2 * u], sc[2 * u + 1]); const bf16x8 pf = __builtin_bit_cast(bf16x8, pw);
#pragma unroll
            for (int dt = 0; dt < 4; ++dt) { const LAS unsigned char* vp = lds + VT_OFF + (16 * dt + fr) * VT_STRIDE + (16 * (T0e + 2 * u) + 4 * fq) * 2;
                const u32x2 lo = *(const LAS u32x2*)vp, hi = *(const LAS u32x2*)(vp + 32);
                const u32x4 vw = (u32x4){lo.x, lo.y, hi.x, hi.y};
                o[dt] = __builtin_amdgcn_mfma_f32_16x16x32_bf16(__builtin_bit_cast(bf16x8, vw), pf, o[dt], 0, 0, 0); } }
        const float inv = 1.0f / l; float ss = 0.f;
        bf16_t* op = AO + (size_t)(tok0 + qi) * 2048 + hq * 64 + 4 * fq;
#pragma unroll
        for (int dt = 0; dt < 4; ++dt) { const f32x4 v = o[dt] * inv; ss += pg8::dot4(v); u32x2 w; w.x = cvt_pk_bf16(v[0], v[1]); w.y = cvt_pk_bf16(v[2], v[3]); *(u32x2*)(op + 16 * dt) = w; }
        ss += __shfl_xor(ss, 16); ss += __shfl_xor(ss, 32);
        partA[(size_t)(tok0 + qi) * 16 + hq] = ss;
    }
}

constexpr int GT_STRIDE = 272, GM_BUF = 128 * GT_STRIDE;
struct GmlpIn { u32x4 a[2], b[2]; f32x4 pa[2], pb[2]; };
__device__ __forceinline__ void gmlp_load(GmlpIn& R, int gu, const bf16_t* GV, const float* partG, int tid) {
    const int b = gu >> 10, chunk = (gu >> 3) & 127, g = gu & 7;
    const int tok0 = b * SEQ + chunk * 128;
#pragma unroll
    for (int it = 0; it < 2; ++it) { const int task = it * NTHREADS + tid, p = task & 63, cc = task >> 6; const int row0 = tok0 + 2 * p;
        const bf16_t* src = GV + (size_t)row0 * 1024 + g * 128 + cc * 8;
        R.a[it] = *(const u32x4*)src; R.b[it] = *(const u32x4*)(src + 1024);
        R.pa[it] = *(const f32x4*)(partG + ((size_t)row0 * 8 + g) * 4); R.pb[it] = *(const f32x4*)(partG + ((size_t)(row0 + 1) * 8 + g) * 4); }
}
__device__ __forceinline__ void gmlp_store_lds(const GmlpIn& R, LAS unsigned char* lds, int tid) {
#pragma unroll
    for (int it = 0; it < 2; ++it) { const int task = it * NTHREADS + tid, p = task & 63, cc = task >> 6;
        const f32x4 pa = R.pa[it], pb = R.pb[it];
        const float rsa = __builtin_amdgcn_rsqf(((pa[0] + pa[1]) + (pa[2] + pa[3])) * (1.0f / 128.0f) + EPS), rsb = __builtin_amdgcn_rsqf(((pb[0] + pb[1]) + (pb[2] + pb[3])) * (1.0f / 128.0f) + EPS);
#pragma unroll
        for (int i = 0; i < 4; ++i) { const unsigned wa = R.a[it][i], wb = R.b[it][i];
            *(LAS unsigned*)(lds + (cc * 8 + 2 * i) * GT_STRIDE + p * 4) = cvt_pk_bf16(bf2f(wa & 0xffffu) * rsa, bf2f(wb & 0xffffu) * rsb);
            *(LAS unsigned*)(lds + (cc * 8 + 2 * i + 1) * GT_STRIDE + p * 4) = cvt_pk_bf16(bf2f(wa >> 16) * rsa, bf2f(wb >> 16) * rsb); } }
}
struct GmlpCur { u32x2 gw[8]; bf16x8 wf[4]; float bias; };
__device__ __forceinline__ void gmlp_cur_load(GmlpCur& C, int gu, const bf16_t* GU, const bf16_t* WSB, const float* bsp, int tid) {
    const int wid = tid >> 6, lane = tid & 63, fr = lane & 15, fq = lane >> 4;
    const int b = gu >> 10, chunk = (gu >> 3) & 127, g = gu & 7;
    const int t = 16 * wid + fr, row = b * SEQ + chunk * 128 + t;
#pragma unroll
    for (int ks = 0; ks < 4; ++ks) C.wf[ks] = *(const bf16x8*)(WSB + (size_t)(g * 128 + t) * 128 + 32 * ks + 8 * fq);
#pragma unroll
    for (int ct = 0; ct < 8; ++ct) C.gw[ct] = *(const u32x2*)(GU + (size_t)row * 1024 + g * 128 + 16 * ct + 4 * fq);
    C.bias = bsp[g * 128 + t];
}
__device__ __forceinline__ void gmlp_compute(LAS unsigned char* lds, int gu, const GmlpCur& C, bf16_t* AO, float* partB, int tid) {
    const int wid = __builtin_amdgcn_readfirstlane(tid >> 6), lane = tid & 63, fr = lane & 15, fq = lane >> 4;
    const int b = gu >> 10, chunk = (gu >> 3) & 127, g = gu & 7;
    const int tok0 = b * SEQ + chunk * 128;
    const int t = 16 * wid + fr, nks = (wid >> 1) + 1, row = tok0 + t;
    const float bias = C.bias;
    f32x4 acc[8];
#pragma unroll
    for (int ct = 0; ct < 8; ++ct) acc[ct] = (f32x4){0.f, 0.f, 0.f, 0.f};
#pragma unroll
    for (int ks = 0; ks < 4; ++ks) if (ks < nks) {
#pragma unroll
        for (int ct = 0; ct < 8; ++ct) { const bf16x8 af = *(const LAS bf16x8*)(lds + (16 * ct + fr) * GT_STRIDE + (32 * ks + 8 * fq) * 2);
            acc[ct] = __builtin_amdgcn_mfma_f32_16x16x32_bf16(af, C.wf[ks], acc[ct], 0, 0, 0); } }
    float ss = 0.f;
#pragma unroll
    for (int ct = 0; ct < 8; ++ct) { const int col = g * 128 + 16 * ct + 4 * fq; const u32x2 gw = C.gw[ct];
        f32x4 v; v[0] = bf2f(gw.x & 0xffffu) * (acc[ct][0] + bias); v[1] = bf2f(gw.x >> 16) * (acc[ct][1] + bias); v[2] = bf2f(gw.y & 0xffffu) * (acc[ct][2] + bias); v[3] = bf2f(gw.y >> 16) * (acc[ct][3] + bias);
        ss += pg8::dot4(v); u32x2 w; w.x = cvt_pk_bf16(v[0], v[1]); w.y = cvt_pk_bf16(v[2], v[3]);
        *(u32x2*)(AO + (size_t)row * 2048 + 1024 + col) = w; }
    ss += __shfl_xor(ss, 16); ss += __shfl_xor(ss, 32);
    partB[(size_t)row * 8 + g] = ss;
}

__device__ __forceinline__ void mixer_phase(LAS unsigned char* lds, unsigned char* ws, const float* sinks, const float* bsp, int tid) {
    const int G = gridDim.x;
    const bf16_t* Qg = (const bf16_t*)(ws + WS_Q); const bf16_t* Kg = (const bf16_t*)(ws + WS_K); const bf16_t* Vg = (const bf16_t*)(ws + WS_V);
    const bf16_t* GU = (const bf16_t*)(ws + WS_GU); const bf16_t* GV = (const bf16_t*)(ws + WS_GV); const bf16_t* WSB = (const bf16_t*)(ws + WS_WSB);
    bf16_t* AO = (bf16_t*)(ws + WS_AO); float* partA = (float*)(ws + WS_PARTA); float* partB = (float*)(ws + WS_PARTB); const float* partG = (const float*)(ws + WS_PARTG);
    {
        constexpr int NA = BATCH * 128 * 4;
        int au = blockIdx.x, par = 0; AttnKV R; bf16x8 q[8], qn[8];
        if (au < NA) { attn_load(R, q, au, Qg, Kg, Vg, tid); attn_store_lds(R, lds, tid); }
        __syncthreads();
        for (; au < NA; au += G) { const int an = au + G; const bool hn = an < NA;
#pragma unroll
            for (int i = 0; i < 8; ++i) qn[i] = q[i];
            const float sink = sinks[(au & 3) * 4 + (__builtin_amdgcn_readfirstlane(tid >> 6) >> 1)] * 1.4426950408889634f;
            asm volatile("" :: "v"(sink));
            if (hn) attn_load(R, qn, an, Qg, Kg, Vg, tid);
            attn_compute(lds + par * ATT_BUF, au, q, AO, partA, sink, tid);
            if (hn) attn_store_lds(R, lds + (par ^ 1) * ATT_BUF, tid);
            __syncthreads();
#pragma unroll
            for (int i = 0; i < 8; ++i) q[i] = qn[i];
            par ^= 1; }
    }
    {
        constexpr int NG = BATCH * 128 * 8;
        int gu = blockIdx.x, par = 0; GmlpIn Ra, Rb; GmlpCur Ca, Cb;
        if (gu < NG) { gmlp_load(Ra, gu, GV, partG, tid); gmlp_cur_load(Ca, gu, GU, WSB, bsp, tid); gmlp_store_lds(Ra, lds, tid); }
        if (gu + G < NG) gmlp_load(Rb, gu + G, GV, partG, tid);
        __syncthreads();
#define GM_ITER(gu_, Rfree, Rnext, Ccur, Cnext) do { const int g1_ = (gu_) + G, g2_ = (gu_) + 2 * G; \
            if (g2_ < NG) gmlp_load(Rfree, g2_, GV, partG, tid); \
            if (g1_ < NG) gmlp_cur_load(Cnext, g1_, GU, WSB, bsp, tid); \
            gmlp_compute(lds + par * GM_BUF, (gu_), Ccur, AO, partB, tid); \
            if (g1_ < NG) gmlp_store_lds(Rnext, lds + (par ^ 1) * GM_BUF, tid); \
            __syncthreads(); par ^= 1; } while (0)
        for (; gu < NG; gu += 2 * G) { GM_ITER(gu, Ra, Rb, Ca, Cb); if (gu + G < NG) GM_ITER(gu + G, Rb, Ra, Cb, Ca); }
#undef GM_ITER
    }
}

#define XB_TMO      128
#define XB_XCNT(j)  (256  + 64 * (j))
#define XB_XSUB(j)  (1280 + 64 * (j))
#define XB_XGEN(j)  (2304 + 64 * (j))
#define XB_TOP      3328
#define XB_TOPGEN   3392
#define XCD_BAR_WORDS 3456
#define XB_SPIN_CAP (1u << 18)

__device__ __forceinline__ unsigned xb_ld(unsigned* p)              { return __hip_atomic_load(p, __ATOMIC_RELAXED, __HIP_MEMORY_SCOPE_AGENT); }
__device__ __forceinline__ unsigned xb_add(unsigned* p, unsigned v) { return __hip_atomic_fetch_add(p, v, __ATOMIC_RELAXED, __HIP_MEMORY_SCOPE_AGENT); }
__device__ __forceinline__ unsigned xb_xcc_id() { return (unsigned)__builtin_amdgcn_s_getreg((3 << 11) | 20) & 0xFu; }
#define XB_SPIN(cond, bar) do { unsigned _sp = 0; while (cond) { __builtin_amdgcn_s_sleep(1); \
    if ((++_sp & 255u) == 0u) { if (xb_ld(&(bar)[XB_TMO])) break; if (_sp > XB_SPIN_CAP) { atomicAdd(&(bar)[XB_TMO], 1u); break; } } } } while (0)

struct XcdBarrier {
    unsigned* bar; unsigned x;
    volatile LAS unsigned* st;
};

__device__ __forceinline__ XcdBarrier xcd_barrier_post(unsigned* bar, volatile LAS unsigned* st) {
    XcdBarrier b; b.bar = bar; b.x = xb_xcc_id(); b.st = st;
    if (threadIdx.x == 0) (void)xb_add(&bar[XB_XCNT(b.x)], 1u);
    return b;
}
__device__ __forceinline__ void xcd_barrier_complete(unsigned* bar, unsigned x, unsigned& nloc, unsigned& nx) {
    const unsigned G = gridDim.x * gridDim.y * gridDim.z;
    unsigned sum, cnt, mine, sp = 0u;
    for (;;) {
        sum = 0u; cnt = 0u; mine = 0u;
#pragma unroll
        for (unsigned j = 0; j < 16; ++j) { const unsigned c = xb_ld(&bar[XB_XCNT(j)]); sum += c; cnt += (c > 0u) ? 1u : 0u; mine = (j == x) ? c : mine; }
        if (sum == G) break;
        __builtin_amdgcn_s_sleep(1);
        if ((++sp & 255u) == 0u) { if (xb_ld(&bar[XB_TMO])) break; if (sp > XB_SPIN_CAP) { atomicAdd(&bar[XB_TMO], 1u); break; } }
    }
    nloc = mine > 0u ? mine : 1u; nx = cnt > 0u ? cnt : 1u;
}

__device__ __forceinline__ void xcd_barrier(const XcdBarrier& b) {
    asm volatile("s_waitcnt vmcnt(0)" ::: "memory");
    __syncthreads();
    if (threadIdx.x == 0) {
        unsigned* bar = b.bar;
        __builtin_amdgcn_s_waitcnt(0);
        unsigned nloc = b.st[0], nx = b.st[1];
        if (nloc == 0u) { xcd_barrier_complete(bar, b.x, nloc, nx); b.st[0] = nloc; b.st[1] = nx; }
        const unsigned old = xb_add(&bar[XB_XSUB(b.x)], 1u);
        const unsigned gen = old / nloc;
        if (old + 1u == (gen + 1u) * nloc) {
            __builtin_amdgcn_fence(__ATOMIC_RELEASE, "agent");
            asm volatile("s_waitcnt vmcnt(0)" ::: "memory");
            const unsigned og = xb_add(&bar[XB_TOP], 1u);
            const unsigned tg = og / nx;
            if (og + 1u == (tg + 1u) * nx) xb_add(&bar[XB_TOPGEN], 1u);
            else XB_SPIN(xb_ld(&bar[XB_TOPGEN]) == tg, bar);
            __builtin_amdgcn_fence(__ATOMIC_ACQUIRE, "agent");
            xb_add(&bar[XB_XGEN(b.x)], 1u);
            asm volatile("s_waitcnt vmcnt(0)" ::: "memory");
        } else {
            XB_SPIN(xb_ld(&bar[XB_XGEN(b.x)]) == gen, bar);
            __builtin_amdgcn_fence(__ATOMIC_ACQUIRE, "agent");
            asm volatile("s_waitcnt vmcnt(0)" ::: "memory");
        }
    }
    __syncthreads();
}

#ifndef MK_SPLIT
#define MK_SPLIT 0
#endif
#define NPHASE 11
#ifndef MK_PROBE_HI1
#define MK_PROBE_HI1 NPHASE
#define MK_PROBE_LO2 0
#endif
__global__ void __launch_bounds__(NTHREADS, 2) hymba_fwd(Args A) {
    extern __shared__ __attribute__((aligned(16))) unsigned char lds_raw[];
    LAS unsigned char* lds = (LAS unsigned char*)lds_raw;
    cg::grid_group grid = cg::this_grid();
    const int tid = threadIdx.x, G = gridDim.x, lo = A.ph_lo, hi = A.ph_hi;
    unsigned char* ws = A.ws;
    float* rsb = (float*)(ws + WS_RS); float *rs1 = rsb, *rs2 = rsb + M, *rsA = rsb + 2 * M, *rsB = rsb + 3 * M, *rs3 = rsb + 4 * M;
    bf16_t* XB = (bf16_t*)(ws + WS_XB); bf16_t* H = (bf16_t*)(ws + WS_H); bf16_t* AO = (bf16_t*)(ws + WS_AO);
    float* part = (float*)(ws + WS_PART); float* partA = (float*)(ws + WS_PARTA); float* partB = (float*)(ws + WS_PARTB); float* partG = (float*)(ws + WS_PARTG);
#define IN(k) (lo <= (k) && (k) < hi)
    volatile LAS unsigned* bst = (volatile LAS unsigned*)(lds + LDS_BYTES - 16);
    if (tid < 4) bst[tid] = 0u;
    __syncthreads();
    const XcdBarrier bar = xcd_barrier_post((unsigned*)(ws + WS_BAR), bst);
#define SEAM(k) do { if (IN(k) && IN((k) + 1)) xcd_barrier(bar); } while (0)
    if (lo < 0) grid.sync();
    if (IN(0)) { p0_prologue(A, lds, tid); __syncthreads(); xcd_barrier(bar);
        quantize_wgu(ws + WS_WGU1, ws + WS_WGU1Q, (const unsigned*)(ws + WS_CMAX1), tid); quantize_wgu(ws + WS_WGU2, ws + WS_WGU2Q, (const unsigned*)(ws + WS_CMAX2), tid); }
    SEAM(0);
    if (IN(1)) {
        pg8::Gemm g{(const bf16_t*)(ws + WS_AQ), (const bf16_t*)(ws + WS_WGU1Q), M, NGU, D / 2}; pg8::StaticOrder S; S.init(M, NGU, G, (int)blockIdx.x);
        pg8::EpiSwiglu<false, true> E{H, rs1, FF, 1.0f, (const unsigned*)(ws + WS_CMAX1)};
        pg8::gemm_phase<pg8::EpiSwiglu<false, true>, pg8::StaticOrder, true, true, 0, 2>(lds, g, S, E);
    }
    SEAM(1);
    if (IN(2)) {
        pg8::Gemm g{H, (const bf16_t*)(ws + WS_WD1), M, D, FF}; pg8::StaticOrder S; S.init(M, D, G, (int)blockIdx.x);
        pg8::EpiResid<false, true, false> E{A.out, XB, part, nullptr, nullptr, 0.5f, nullptr};
        pg8::gemm_phase<pg8::EpiResid<false, true, false>, pg8::StaticOrder, true, true>(lds, g, S, E);
    }
    SEAM(2);
#define MY_PANELS(S_, ...) do { int prev_ = -1; pg8::Unit u_; for (int i_ = 0; (S_).next(i_, u_); ++i_) if (u_.pm != prev_) { prev_ = u_.pm; if (tid < 256) { const int m = u_.pm * 256 + tid; __VA_ARGS__ } } asm volatile("s_waitcnt vmcnt(0)" ::: "memory"); __syncthreads(); } while (0)
    if (IN(4)) {
        pg8::Gemm g{XB, (const bf16_t*)(ws + WS_WIN), M, NIN, D}; pg8::StaticOrder S; S.init(M, NIN, G, (int)blockIdx.x);
        MY_PANELS(S, { const f32x4* p = (const f32x4*)(part + (size_t)m * 32); float sm = 0.f;
            for (int j = 0; j < 8; ++j) { const f32x4 v = p[j]; sm += (v[0] + v[1]) + (v[2] + v[3]); }
            rs2[m] = __builtin_amdgcn_rsqf(sm * (1.0f / D) + EPS); });
        pg8::EpiIn E{(bf16_t*)(ws + WS_Q), (bf16_t*)(ws + WS_K), (bf16_t*)(ws + WS_V), (bf16_t*)(ws + WS_GU), (bf16_t*)(ws + WS_GV), rs2,
                     (const float*)A.in[8], (const float*)A.in[9], (const float*)A.in[11], (const float*)(ws + WS_CS), partG};
        pg8::gemm_phase<pg8::EpiIn, pg8::StaticOrder, true, true>(lds, g, S, E);
    }
    SEAM(4);
    if (IN(5)) mixer_phase(lds, ws, (const float*)A.in[10], (const float*)A.in[13], tid);
    SEAM(5);
    if (IN(7)) {
        pg8::Gemm g{AO, (const bf16_t*)(ws + WS_WOUT), M, D, D}; pg8::StaticOrder S; S.init(M, D, G, (int)blockIdx.x);
        MY_PANELS(S, { const f32x4* pa = (const f32x4*)(partA + (size_t)m * 16); const f32x4* pb = (const f32x4*)(partB + (size_t)m * 8); float sa = 0.f, sb = 0.f;
            for (int j = 0; j < 4; ++j) { const f32x4 v = pa[j]; sa += (v[0] + v[1]) + (v[2] + v[3]); }
            for (int j = 0; j < 2; ++j) { const f32x4 v = pb[j]; sb += (v[0] + v[1]) + (v[2] + v[3]); }
            const float ra = __builtin_amdgcn_rsqf(sa * (1.0f / 1024.0f) + EPS), rb = __builtin_amdgcn_rsqf(sb * (1.0f / 1024.0f) + EPS);
            rsA[m] = ra / rb; rsB[m] = rb; });
        pg8::EpiResid<true, true, false> E{A.out, XB, part, rsA, rsB, 0.f, (float*)(ws + WS_PMAX)};
        pg8::gemm_phase<pg8::EpiResid<true, true, false>, pg8::StaticOrder, true, true, 1024>(lds, g, S, E);
    }
    SEAM(7);
    if (IN(8)) quantize_x2(ws, part, rs3, tid);
    SEAM(8);
    if (IN(9)) {
        pg8::Gemm g{(const bf16_t*)(ws + WS_AQ), (const bf16_t*)(ws + WS_WGU2Q), M, NGU, D / 2}; pg8::StaticOrder S; S.init(M, NGU, G, (int)blockIdx.x);
        pg8::EpiSwiglu<true, true> E{H, rs3, FF, 4.0f, (const unsigned*)(ws + WS_CMAX2)};
        pg8::gemm_phase<pg8::EpiSwiglu<true, true>, pg8::StaticOrder, true, true, 0, 2>(lds, g, S, E);
    }
    SEAM(9);
    if (IN(10)) {
        pg8::Gemm g{H, (const bf16_t*)(ws + WS_WD2), M, D, FF / 2}; pg8::StaticOrder S; S.init(M, D, G, (int)blockIdx.x);
        pg8::EpiResid<false, false, true> E{A.out, XB, nullptr, nullptr, nullptr, 0.5f / (64.0f * 4.0f), nullptr};
        pg8::gemm_phase<pg8::EpiResid<false, false, true>, pg8::StaticOrder, true, true, 0, 1>(lds, g, S, E);
    }
#undef IN
#undef SEAM
}

extern "C" void kernel_launch(void* const* d_in, const int* in_sizes, int n_in, void* d_out, int out_size, void* d_ws, size_t ws_size, hipStream_t stream) {
    static int grid = 0;
    if (grid == 0) {
        if (n_in != 21 || in_sizes[0] != M * D || out_size != M * D || ws_size < WS_END) { fprintf(stderr, "kernel_launch: unexpected shapes (n_in %d, in0 %d, out %d, ws %zu); nothing launched\n", n_in, n_in > 0 ? in_sizes[0] : -1, out_size, ws_size); grid = -1; return; }
        int dev = 0, cus = 0, per_cu = 0;
        if (hipGetDevice(&dev) != hipSuccess || hipDeviceGetAttribute(&cus, hipDeviceAttributeMultiprocessorCount, dev) != hipSuccess) { grid = -1; return; }
        if (hipFuncSetAttribute((const void*)hymba_fwd, hipFuncAttributeMaxDynamicSharedMemorySize, LDS_BYTES) != hipSuccess) { fprintf(stderr, "kernel_launch: hipFuncSetAttribute failed\n"); grid = -1; return; }
        if (hipOccupancyMaxActiveBlocksPerMultiprocessor(&per_cu, (const void*)hymba_fwd, NTHREADS, LDS_BYTES) != hipSuccess || per_cu < 1) per_cu = 1;
        (void)hipGetLastError();
        grid = cus * per_cu;
    }
    if (grid < 0) return;
    if (hipMemsetAsync((char*)d_ws + WS_BAR, 0, CTL_ZERO_BYTES, stream) != hipSuccess) { fprintf(stderr, "kernel_launch: hipMemsetAsync failed\n"); return; }
    Args a{};
    for (int i = 0; i < 21; ++i) a.in[i] = d_in[i];
    a.out = (float*)d_out; a.ws = (unsigned char*)d_ws;
    void* args[] = {&a};
    a.ph_lo = 0; a.ph_hi = NPHASE;
    hipError_t e = hipLaunchCooperativeKernel((const void*)hymba_fwd, dim3(grid), dim3(NTHREADS), args, LDS_BYTES, stream);
    if (e != hipSuccess) fprintf(stderr, "kernel_launch: cooperative launch failed: %s (grid %d)\n", hipGetErrorString(e), grid);
}
```
